# Optimizing an MI355X kernel written in HIP

```python
import jax
import jax.numpy as jnp
from jax import lax
import numpy as np

D_MODEL = 1024
BATCH = 2
SEQ = 8192
DEPTH = 2
DEC_BATCH = 32
DEC_SEQ = 4
PAST_LEN = 8192
PAGE_SIZE = 128

CHUNK = 128
A_GROUPS = 4
A_GROUP_DIM = 128
A_WIDTH = A_GROUPS * A_GROUP_DIM
HEAD_DIM = 64
KV_HEADS = 4
DIL_PAIRS = ((128, 1), (512, 4), (2048, 16))
N_DIL = len(DIL_PAIRS)
Q_HEADS = N_DIL * KV_HEADS
Q_W = Q_HEADS * HEAD_DIM
KV_W = KV_HEADS * HEAD_DIM
BAND = 128
MAX_WINDOW = 2048
C_WIDTH = 512
CONV_W = 3
D_FF = -(-(8 * D_MODEL) // (3 * 256)) * 256
EPS = 1e-6

SPLIT_SIZES = (A_WIDTH, A_WIDTH, Q_W, KV_W, KV_W, C_WIDTH, C_WIDTH, C_WIDTH, D_MODEL, D_MODEL, D_MODEL)
SPLIT_IDX = tuple(sum(SPLIT_SIZES[:i + 1]) for i in range(len(SPLIT_SIZES) - 1))
IN_W = sum(SPLIT_SIZES)

kernel_name = 'hybrid_gated_gmlp_dilated_conv_decoder_step'


def rms_norm(x, g):
    xf = x.astype(jnp.float32)
    y = xf * lax.rsqrt(jnp.mean(xf * xf, axis=-1, keepdims=True) + EPS)
    return (y * g).astype(x.dtype)


def layer_norm(x, g, b):
    xf = x.astype(jnp.float32)
    mu = jnp.mean(xf, axis=-1, keepdims=True)
    xc = xf - mu
    y = xc * lax.rsqrt(jnp.mean(xc * xc, axis=-1, keepdims=True) + EPS)
    return (y * g + b).astype(x.dtype)


def alibi_slopes():
    s = [2.0 ** (-8.0 * (i + 1) / Q_HEADS) for i in range(Q_HEADS)]
    return jnp.asarray(s, jnp.float32).reshape(N_DIL, KV_HEADS)


def split_proj(h, w_in):
    z = jnp.einsum('bsd,de->bse', h, w_in)
    return jnp.split(z, SPLIT_IDX, axis=-1)


def gmlp_inputs(u_raw, v_raw, ln_g, ln_b):
    return jax.nn.gelu(u_raw), layer_norm(jax.nn.gelu(v_raw), ln_g, ln_b)


def spatial_gate(v, w_s, b_s):
    L = v.shape[-3]
    w = jnp.tril(w_s[:, :L, :L])
    return jnp.einsum('gts,...sgc->...tgc', w, v) + jnp.transpose(b_s[:, :L])[:, :, None]


def banded_group(q, k, v, slopes, dil):
    Bn, S, H, D = q.shape
    span = dil * BAND
    Sp = -(-S // span) * span
    J = Sp // dil
    nb = J // BAND

    def to_blocks(a):
        a = jnp.pad(a, ((0, 0), (0, Sp - S), (0, 0), (0, 0)))
        a = a.reshape(Bn, J, dil, H, D).transpose(0, 2, 1, 3, 4)
        return a.reshape(Bn, dil, nb, BAND, H, D)

    def with_prev(a):
        prev = jnp.pad(a, ((0, 0), (0, 0), (1, 0), (0, 0), (0, 0), (0, 0)))[:, :, :-1]
        return jnp.concatenate([prev, a], axis=3)

    qb = to_blocks(q)
    kb = with_prev(to_blocks(k))
    vb = with_prev(to_blocks(v))
    s = jnp.einsum('brnqhd,brnkhd->brnhqk', qb, kb, preferred_element_type=jnp.float32) * (HEAD_DIM ** -0.5)
    dist = (jnp.arange(BAND)[:, None] + BAND) - jnp.arange(2 * BAND)[None, :]
    valid = ((dist >= 0) & (dist <= BAND))[None] & (
        (jnp.arange(nb)[:, None, None] > 0) | (jnp.arange(2 * BAND)[None, None, :] >= BAND))
    s = s - (slopes * dil)[:, None, None] * dist.astype(jnp.float32)
    s = jnp.where(valid[None, None, :, None], s, -jnp.inf)
    m = jnp.max(s, axis=-1, keepdims=True)
    p = jnp.exp(s - m)
    den = jnp.sum(p, axis=-1)
    o = jnp.einsum('brnhqk,brnkhd->brnqhd', p, vb) / jnp.transpose(den, (0, 1, 2, 4, 3))[..., None]
    lse = m[..., 0] + jnp.log(den)
    o = o.reshape(Bn, dil, J, H, D).transpose(0, 2, 1, 3, 4).reshape(Bn, Sp, H, D)[:, :S]
    lse = jnp.transpose(lse, (0, 1, 2, 4, 3)).reshape(Bn, dil, J, H).transpose(0, 2, 1, 3).reshape(Bn, Sp, H)[:, :S]
    return o, lse


def combine_groups(outs, lses):
    w = jax.nn.softmax(jnp.stack(lses), axis=0)
    return jnp.sum(w[..., None] * jnp.stack(outs), axis=0)


def dilated_attn_prompt(q, k, v):
    slopes = alibi_slopes()
    outs, lses = [], []
    for g, (_, dil) in enumerate(DIL_PAIRS):
        o, l = banded_group(q[:, :, g], k, v, slopes[g], dil)
        outs.append(o)
        lses.append(l)
    return combine_groups(outs, lses).astype(v.dtype)


def dilated_attn_sample(q, k_all, v_all, L):
    T = q.shape[1]
    slopes = alibi_slopes()
    taps = jnp.arange(BAND + 1)
    outs, lses = [], []
    for g, (_, dil) in enumerate(DIL_PAIRS):
        idx = L + jnp.arange(T)[:, None] - dil * taps[None, :]
        valid = idx >= 0
        idx = jnp.maximum(idx, 0)
        kg = k_all[:, idx]
        vg = v_all[:, idx]
        s = jnp.einsum('bthd,btkhd->bthk', q[:, :, g], kg, preferred_element_type=jnp.float32) * (HEAD_DIM ** -0.5)
        s = s - (slopes[g] * dil)[:, None] * taps.astype(jnp.float32)[None, :]
        s = jnp.where(valid[None, :, None, :], s, -jnp.inf)
        m = jnp.max(s, axis=-1, keepdims=True)
        p = jnp.exp(s - m)
        den = jnp.sum(p, axis=-1)
        outs.append(jnp.einsum('bthk,btkhd->bthd', p, vg) / den[..., None])
        lses.append(m[..., 0] + jnp.log(den))
    return combine_groups(outs, lses).astype(v_all.dtype)


def short_conv(z, prev, w, b):
    T = z.shape[1]
    zp = jnp.concatenate([prev.astype(z.dtype), z], axis=1)
    y = b + sum(w[i] * zp[:, i:i + T] for i in range(CONV_W))
    return y, zp[:, T:]


def merge_branches(out_a, out_b, out_c, ga, gb, gc, b_gate, w_br_a, w_br_b, w_br_c, w_o):
    bga, bgb, bgc = jnp.split(b_gate, 3)
    merged = (jax.nn.sigmoid(ga + bga) * (out_a @ w_br_a)
              + jax.nn.sigmoid(gb + bgb) * (out_b @ w_br_b)
              + jax.nn.sigmoid(gc + bgc) * (out_c @ w_br_c))
    return merged @ w_o


def mixer_prompt(h, w_in, a_ln_g, a_ln_b, a_ws, a_bs, c_conv_w, c_conv_b, w_br_a, w_br_b, w_br_c, b_gate, w_o):
    Bn, S, _ = h.shape
    ua, va, q, k, v, cx, cb, cc, ga, gb, gc = split_proj(h, w_in)
    u, vn = gmlp_inputs(ua, va, a_ln_g, a_ln_b)
    sa = spatial_gate(vn.reshape(Bn, S // CHUNK, CHUNK, A_GROUPS, A_GROUP_DIM), a_ws, a_bs).reshape(Bn, S, A_WIDTH)
    out_a = u * sa
    k = k.reshape(Bn, S, KV_HEADS, HEAD_DIM)
    v = v.reshape(Bn, S, KV_HEADS, HEAD_DIM)
    out_b = dilated_attn_prompt(q.reshape(Bn, S, N_DIL, KV_HEADS, HEAD_DIM), k, v).reshape(Bn, S, KV_W)
    conv, conv_state = short_conv(cc * cx, jnp.zeros((Bn, CONV_W - 1, C_WIDTH), h.dtype), c_conv_w, c_conv_b)
    out_c = cb * conv
    y = merge_branches(out_a, out_b, out_c, ga, gb, gc, b_gate, w_br_a, w_br_b, w_br_c, w_o)
    win = min(MAX_WINDOW, S)
    return y, k[:, S - win:], v[:, S - win:], conv_state


def mixer_sample(h, cache_k, cache_v, conv_prev, w_in, a_ln_g, a_ln_b, a_ws, a_bs, c_conv_w, c_conv_b,
                 w_br_a, w_br_b, w_br_c, b_gate, w_o):
    Bn, T, _ = h.shape
    ua, va, q, k, v, cx, cb, cc, ga, gb, gc = split_proj(h, w_in)
    u, vn = gmlp_inputs(ua, va, a_ln_g, a_ln_b)
    sa = spatial_gate(vn.reshape(Bn, T, A_GROUPS, A_GROUP_DIM), a_ws, a_bs).reshape(Bn, T, A_WIDTH)
    out_a = u * sa
    k = k.reshape(Bn, T, KV_HEADS, HEAD_DIM)
    v = v.reshape(Bn, T, KV_HEADS, HEAD_DIM)
    L = cache_k.shape[1]
    k_all = jnp.concatenate([cache_k.astype(k.dtype), k], axis=1)
    v_all = jnp.concatenate([cache_v.astype(v.dtype), v], axis=1)
    out_b = dilated_attn_sample(q.reshape(Bn, T, N_DIL, KV_HEADS, HEAD_DIM), k_all, v_all, L).reshape(Bn, T, KV_W)
    conv, conv_state = short_conv(cc * cx, conv_prev, c_conv_w, c_conv_b)
    out_c = cb * conv
    y = merge_branches(out_a, out_b, out_c, ga, gb, gc, b_gate, w_br_a, w_br_b, w_br_c, w_o)
    return y, k, v, conv_state, vn


def swiglu(h, wg, wu, wd):
    return (jax.nn.silu(h @ wg) * (h @ wu)) @ wd


def setup_inputs(seed: int = 0) -> dict:
    key = jax.random.key(seed)
    ks = jax.random.split(key, 24)
    f32 = jnp.float32

    def nrm(i, shape, scale):
        return jax.random.normal(ks[i], shape, f32) * scale

    win = min(MAX_WINDOW, PAST_LEN)
    return {
        'x_prompt': nrm(0, (BATCH, SEQ, D_MODEL), 1.0),
        'x_sample': nrm(1, (DEC_BATCH, DEC_SEQ, D_MODEL), 1.0),
        'cache_k_win': nrm(2, (DEPTH, DEC_BATCH, win, KV_HEADS, HEAD_DIM), 1.0),
        'cache_v_win': nrm(3, (DEPTH, DEC_BATCH, win, KV_HEADS, HEAD_DIM), 1.0),
        'state_conv': nrm(4, (DEPTH, DEC_BATCH, CONV_W - 1, C_WIDTH), 1.0),
        'g_pre_mix': 1.0 + nrm(5, (DEPTH, D_MODEL), 0.02),
        'g_post_mix': 1.0 + nrm(6, (DEPTH, D_MODEL), 0.02),
        'g_pre_ffn': 1.0 + nrm(7, (DEPTH, D_MODEL), 0.02),
        'g_post_ffn': 1.0 + nrm(8, (DEPTH, D_MODEL), 0.02),
        'w_in': nrm(9, (DEPTH, D_MODEL, IN_W), D_MODEL ** -0.5),
        'a_ln_g': 1.0 + nrm(10, (DEPTH, A_WIDTH), 0.02),
        'a_ln_b': nrm(11, (DEPTH, A_WIDTH), 0.02),
        'a_ws': nrm(12, (DEPTH, A_GROUPS, CHUNK, CHUNK), CHUNK ** -0.5),
        'a_bs': 1.0 + nrm(13, (DEPTH, A_GROUPS, CHUNK), 0.02),
        'c_conv_w': nrm(14, (DEPTH, CONV_W, C_WIDTH), CONV_W ** -0.5),
        'c_conv_b': nrm(15, (DEPTH, C_WIDTH), 0.02),
        'w_br_a': nrm(16, (DEPTH, A_WIDTH, D_MODEL), A_WIDTH ** -0.5),
        'w_br_b': nrm(17, (DEPTH, KV_W, D_MODEL), KV_W ** -0.5),
        'w_br_c': nrm(18, (DEPTH, C_WIDTH, D_MODEL), C_WIDTH ** -0.5),
        'b_gate': nrm(19, (DEPTH, 3 * D_MODEL), 0.02),
        'w_o': nrm(20, (DEPTH, D_MODEL, D_MODEL), D_MODEL ** -0.5),
        'w_ff_gate': nrm(21, (DEPTH, D_MODEL, D_FF), D_MODEL ** -0.5),
        'w_ff_up': nrm(22, (DEPTH, D_MODEL, D_FF), D_MODEL ** -0.5),
        'w_ff_down': nrm(23, (DEPTH, D_FF, D_MODEL), D_FF ** -0.5),
    }


def reference(x_prompt, x_sample, cache_k_win, cache_v_win, state_conv,
              g_pre_mix, g_post_mix, g_pre_ffn, g_post_ffn, w_in,
              a_ln_g, a_ln_b, a_ws, a_bs, c_conv_w, c_conv_b,
              w_br_a, w_br_b, w_br_c, b_gate, w_o, w_ff_gate, w_ff_up, w_ff_down):
    xp, xs = x_prompt, x_sample
    kp_l, vp_l, ks_l, vs_l, cp_l, cs_l, av_l = [], [], [], [], [], [], []
    for l in range(DEPTH):
        mix_w = (w_in[l], a_ln_g[l], a_ln_b[l], a_ws[l], a_bs[l], c_conv_w[l], c_conv_b[l],
                 w_br_a[l], w_br_b[l], w_br_c[l], b_gate[l], w_o[l])
        mp, kp, vp, cp = mixer_prompt(rms_norm(xp, g_pre_mix[l]), *mix_w)
        ms, kn, vnw, cs, av = mixer_sample(rms_norm(xs, g_pre_mix[l]), cache_k_win[l], cache_v_win[l],
                                           state_conv[l], *mix_w)
        xp = xp + rms_norm(mp, g_post_mix[l])
        xs = xs + rms_norm(ms, g_post_mix[l])
        xp = xp + rms_norm(swiglu(rms_norm(xp, g_pre_ffn[l]), w_ff_gate[l], w_ff_up[l], w_ff_down[l]), g_post_ffn[l])
        xs = xs + rms_norm(swiglu(rms_norm(xs, g_pre_ffn[l]), w_ff_gate[l], w_ff_up[l], w_ff_down[l]), g_post_ffn[l])
        kp_l.append(kp)
        vp_l.append(vp)
        ks_l.append(kn)
        vs_l.append(vnw)
        cp_l.append(cp)
        cs_l.append(cs)
        av_l.append(av)
    return (xp, xs, jnp.stack(kp_l), jnp.stack(vp_l), jnp.stack(ks_l), jnp.stack(vs_l),
            jnp.stack(cp_l), jnp.stack(cs_l), jnp.stack(av_l))
```

```cpp
#include <hip/hip_runtime.h>
#include <hip/hip_cooperative_groups.h>
#include <cstdio>
#include <cstdint>
namespace cg = cooperative_groups;

#ifndef ONE_LAUNCH
#define ONE_LAUNCH 0
#endif

#define LAS __attribute__((address_space(3)))
typedef unsigned short bf16_t;
typedef short bf16x8 __attribute__((ext_vector_type(8)));
typedef short bf16x4 __attribute__((ext_vector_type(4)));
typedef float f32x4 __attribute__((ext_vector_type(4)));
typedef float f32x2 __attribute__((ext_vector_type(2)));
typedef unsigned u32x4 __attribute__((ext_vector_type(4)));
typedef unsigned u32x2 __attribute__((ext_vector_type(2)));

constexpr int DM = 1024, SEQ = 8192, MPR = 16384, MSM = 128, MR = MPR + MSM, MPAD = 16640;
constexpr int INW = 6912, ZW = 3840, GW = 3072, FF = 2816, MIXW = 1280;
constexpr int ZC_U = 0, ZC_GV = 512, ZC_Q = 1024, ZC_K = 1792, ZC_V = 2048, ZC_CX = 2304, ZC_CB = 2816, ZC_CC = 3328;
constexpr float EPS = 1e-6f;
constexpr size_t O_Y = 0, O_KWIN = 16908288, O_VWIN = 19005440, O_KROW = 21102592, O_VROW = 21168128, O_CONVP = 21233664, O_CONVS = 21237760, O_AV = 21303296;
constexpr size_t MiB = 1u << 20;
constexpr size_t WS_W = 1 * MiB, W_LAYER = 36 * MiB;
constexpr size_t WO_IN = 0, WO_BR = 14155776, WO_O = WO_BR + 2621440, WO_GU = WO_O + 2097152, WO_D = WO_GU + 11534336;
static_assert(WO_D + 5767168 <= W_LAYER, "weights");
constexpr size_t WS_R1 = 73 * MiB;
constexpr size_t WS_R2 = 114 * MiB;
constexpr size_t WS_R3 = 147 * MiB;
constexpr size_t WS_Z1 = 180 * MiB;
constexpr size_t WS_G = 302 * MiB;
constexpr size_t WS_END = 400 * MiB;
constexpr size_t R3_LSE = (size_t)3 * MPR * 256 * 2;

constexpr int LDS_BYTES = 147456;

__device__ __forceinline__ unsigned f2bf(float f) { unsigned u = __builtin_bit_cast(unsigned, f); return (u + 0x7fffu + ((u >> 16) & 1u)) >> 16; }
__device__ __forceinline__ unsigned pk2(float lo, float hi) { return f2bf(lo) | (f2bf(hi) << 16); }
__device__ __forceinline__ float bflo(unsigned w) { return __builtin_bit_cast(float, w << 16); }
__device__ __forceinline__ float bfhi(unsigned w) { return __builtin_bit_cast(float, w & 0xffff0000u); }
__device__ __forceinline__ float bf1(bf16_t b) { return __builtin_bit_cast(float, (unsigned)b << 16); }
__device__ __forceinline__ float sigm(float x) { return __builtin_amdgcn_rcpf(1.f + __expf(-x)); }
__device__ __forceinline__ float gelu_t(float x) { return x * sigm(1.5957691216057308f * x * (1.f + 0.044715f * x * x)); }
__device__ __forceinline__ float wave_sum(float v) {
#pragma unroll
    for (int o = 1; o < 64; o <<= 1) v += __shfl_xor(v, o);
    return v;
}
__device__ __forceinline__ int opaque_bid() { int b = blockIdx.x; asm volatile("" : "+s"(b)); return b; }
__device__ __forceinline__ int opaque_tid() { int t = threadIdx.x; asm volatile("" : "+v"(t)); return t; }
#define LDS_WAIT() asm volatile("s_waitcnt lgkmcnt(0)" ::: "memory")

namespace pg8 {
constexpr int BM = 256, BK = 64, HALF = 128, HTB = HALF * BK * 2, STAGE_BYTES = 8 * HTB, NXCD = 8, WGM = 8;
__host__ __device__ __forceinline__ int lds_byte(int r, int c) { const int st = (r >> 4) * 2 + (c >> 5), rr = r & 15, cc = c & 31, ob = rr * 64 + cc * 2; return st * 1024 + (ob ^ (((ob >> 9) & 1) << 5)); }
__host__ __device__ __forceinline__ void stage_rc(int b, int& R, int& C) { const int st = b / 1024, sb = b % 1024, swz = sb ^ (((sb >> 9) & 1) << 5); R = (st >> 1) * 16 + swz / 64; C = (st & 1) * 32 + (swz % 64) / 2; }
__host__ __device__ __forceinline__ int perm32(int rho) { const int n = rho >> 4, i = rho & 15; return 8 * (i >> 2) + 4 * n + (i & 3); }

struct Unit { int pm, pn; };
struct Gemm { const bf16_t* A; const bf16_t* Bt; };

struct StaticOrder {
    int nM, nN, nwg, G, c;
    __host__ __device__ void init(int M, int N, int G_, int c_) { nM = M / BM; nN = N / BM; nwg = nM * nN; G = G_; c = c_; }
    __host__ __device__ bool next(int i, Unit& u) const {
        const long L = (long)i * G + c; if (L >= nwg) return false;
        int wgid = (int)L; { const int q = nwg / NXCD, r = nwg % NXCD, xcd = wgid % NXCD, off = wgid / NXCD; wgid = (xcd < r ? xcd * (q + 1) : r * (q + 1) + (xcd - r) * q) + off; }
        const int nig = WGM * nN, gid = wgid / nig, fm = gid * WGM, gsz = (nM - fm) < WGM ? (nM - fm) : WGM;
        u.pm = fm + ((wgid % nig) % gsz); u.pn = (wgid % nig) / gsz; return true;
    }
};

template <class Epi, bool ALIGN_EPI, int K_, int LDA_, int LDB_>
__device__ __forceinline__ void gemm_phase(LAS unsigned char* lds, const Gemm g, const StaticOrder& S, const Epi& E) {
    int tid_ = threadIdx.x; asm volatile("" : "+v"(tid_));
    const int tid = tid_, wid = __builtin_amdgcn_readfirstlane(tid >> 6), lane = tid & 63, wr = wid >> 2, wc = wid & 3, fr = lane & 15, fq = lane >> 4;
    constexpr int nt = K_ / BK;
    unsigned voffA[2], voffB[2];
#pragma unroll
    for (int i = 0; i < 2; ++i) { int R, C; stage_rc(tid * 16 + i * 8192, R, C); const int Rb = Epi::PERM ? ((R & ~31) + perm32(R & 31)) : R;
        voffA[i] = (unsigned)(R * LDA_ + C) * 2u; voffB[i] = (unsigned)(Rb * LDB_ + C) * 2u; }
    constexpr size_t kstep = (size_t)(BK * 2);
    constexpr size_t hstepA = (size_t)HALF * LDA_ * 2, hstepB = (size_t)HALF * LDB_ * 2;
    constexpr size_t tstepA = 2 * hstepA, tstepB = 2 * hstepB;
    const unsigned ldsw = (unsigned)wid * 1024u;
    const int aoff = lds_byte(wr * 64 + fr, fq * 8), boff = lds_byte(wc * 32 + fr, fq * 8);
#define PG8_SA(b, h) (((b) * 2 + (h)) * HTB)
#define PG8_SB(b, h) ((4 + (b) * 2 + (h)) * HTB)
#define PG8_STAGE(bufoff, gbase, voff) do { _Pragma("unroll") for (int _i = 0; _i < 2; ++_i) \
        __builtin_amdgcn_global_load_lds((const unsigned*)((const char*)(gbase) + (voff)[_i]), (LAS unsigned*)(lds + (bufoff) + ldsw + _i * 8192), 16, 0, 0); } while (0)
#define PG8_LDA(dst, b, h) do { _Pragma("unroll") for (int m = 0; m < 4; ++m) _Pragma("unroll") for (int k = 0; k < 2; ++k) dst[m][k] = *(const LAS bf16x8*)(lds + PG8_SA(b, h) + aoff + m * 2048 + k * 1024); } while (0)
#define PG8_LDB(dst, b, h) do { _Pragma("unroll") for (int n = 0; n < 2; ++n) _Pragma("unroll") for (int k = 0; k < 2; ++k) dst[n][k] = *(const LAS bf16x8*)(lds + PG8_SB(b, h) + boff + n * 2048 + k * 1024); } while (0)
#define PG8_MMA(ai, bj, At, Bt) do { __builtin_amdgcn_s_setprio(1); _Pragma("unroll") for (int m = 0; m < 4; ++m) _Pragma("unroll") for (int n = 0; n < 2; ++n) _Pragma("unroll") for (int k = 0; k < 2; ++k) \
        acc[ai][bj][m][n] = __builtin_amdgcn_mfma_f32_16x16x32_bf16(Bt[n][k], At[m][k], acc[ai][bj][m][n], 0, 0, 0); __builtin_amdgcn_s_setprio(0); } while (0)
#define PG8_WAIT_V(n) asm volatile("s_waitcnt vmcnt(" #n ")" ::: "memory")
#define PG8_WAIT_L(n) asm volatile("s_waitcnt lgkmcnt(" #n ")" ::: "memory")
#define PG8_BAR __builtin_amdgcn_s_barrier()
#define PG8_SCHED __builtin_amdgcn_sched_barrier(0)
    Unit cur, nxt; int ui = 0;
    if (!S.next(0, cur)) return;
    f32x4 acc[2][2][4][2];
#pragma unroll
    for (int a = 0; a < 2; ++a)
#pragma unroll
        for (int b = 0; b < 2; ++b)
#pragma unroll
            for (int m = 0; m < 4; ++m)
#pragma unroll
                for (int n = 0; n < 2; ++n) acc[a][b][m][n] = (f32x4){0.f, 0.f, 0.f, 0.f};
    bf16x8 At[4][2], B0[2][2], B1[2][2];
    const char* cA = (const char*)g.A + (size_t)cur.pm * tstepA; const char* cB = (const char*)g.Bt + (size_t)cur.pn * tstepB;
    PG8_SCHED; PG8_STAGE(PG8_SB(0, 0), cB, voffB); PG8_SCHED; PG8_STAGE(PG8_SB(0, 1), cB + hstepB, voffB); PG8_SCHED; PG8_STAGE(PG8_SA(0, 0), cA, voffA); PG8_SCHED; PG8_STAGE(PG8_SA(0, 1), cA + hstepA, voffA); PG8_SCHED;
    if (wr == 1) PG8_BAR;
    PG8_WAIT_V(2); PG8_BAR; PG8_SCHED;
    PG8_STAGE(PG8_SB(1, 0), cB + kstep, voffB); PG8_SCHED; PG8_STAGE(PG8_SA(1, 0), cA + kstep, voffA); PG8_SCHED; PG8_STAGE(PG8_SB(1, 1), cB + hstepB + kstep, voffB); PG8_SCHED;
    PG8_WAIT_V(6); PG8_BAR; PG8_SCHED;
    for (;;) {
        const bool has_next = S.next(ui + 1, nxt);
        const char* nA = has_next ? (const char*)g.A + (size_t)nxt.pm * tstepA : cA; const char* nB = has_next ? (const char*)g.Bt + (size_t)nxt.pn * tstepB : cB;
        for (int t = 0; t < nt; t += 2) {
            const bool last = (t == nt - 2);
            const char* a1 = cA + (size_t)(t + 1) * kstep;
            const char* a2 = last ? nA : cA + (size_t)(t + 2) * kstep; const char* b2 = last ? nB : cB + (size_t)(t + 2) * kstep;
            const char* a3 = a2 + kstep; const char* b3 = b2 + kstep;
            PG8_LDB(B0, 0, 0); PG8_LDB(B1, 0, 1); PG8_SCHED; PG8_LDA(At, 0, 0); PG8_STAGE(PG8_SA(1, 1), a1 + hstepA, voffA);
            PG8_WAIT_V(8); PG8_WAIT_L(0); PG8_BAR; PG8_MMA(0, 0, At, B0); PG8_MMA(0, 1, At, B1); PG8_BAR; PG8_SCHED;
            PG8_LDA(At, 0, 1); PG8_STAGE(PG8_SB(0, 0), b2, voffB); PG8_STAGE(PG8_SB(0, 1), b2 + hstepB, voffB); PG8_STAGE(PG8_SA(0, 0), a2, voffA);
            PG8_WAIT_V(8); PG8_WAIT_L(0); PG8_BAR; PG8_MMA(1, 0, At, B0); PG8_MMA(1, 1, At, B1); PG8_BAR; PG8_SCHED;
            PG8_LDB(B0, 1, 0); PG8_LDB(B1, 1, 1); PG8_SCHED; PG8_LDA(At, 1, 0); PG8_STAGE(PG8_SA(0, 1), a2 + hstepA, voffA);
            PG8_WAIT_V(8); PG8_WAIT_L(0); PG8_BAR; PG8_MMA(0, 0, At, B0); PG8_MMA(0, 1, At, B1); PG8_BAR; PG8_SCHED;
            PG8_LDA(At, 1, 1); PG8_STAGE(PG8_SB(1, 0), b3, voffB); PG8_STAGE(PG8_SB(1, 1), b3 + hstepB, voffB); PG8_STAGE(PG8_SA(1, 0), a3, voffA);
            PG8_WAIT_V(8); PG8_WAIT_L(0); PG8_BAR; PG8_MMA(1, 0, At, B0); PG8_MMA(1, 1, At, B1); PG8_BAR; PG8_SCHED;
        }
        if constexpr (ALIGN_EPI) { if (wr == 0) PG8_BAR; }
        E(acc, cur, wr, wc, fr, fq);
        if (!has_next) break;
#pragma unroll
        for (int a = 0; a < 2; ++a)
#pragma unroll
            for (int b = 0; b < 2; ++b)
#pragma unroll
                for (int m = 0; m < 4; ++m)
#pragma unroll
                    for (int n = 0; n < 2; ++n) acc[a][b][m][n] = (f32x4){0.f, 0.f, 0.f, 0.f};
        cur = nxt; cA = nA; cB = nB; ++ui;
        if constexpr (ALIGN_EPI) { if (wr == 1) PG8_BAR; }
    }
    PG8_WAIT_V(0);
    if constexpr (!ALIGN_EPI) { if (wr == 0) PG8_BAR; }
    PG8_BAR;
#undef PG8_SA
#undef PG8_SB
#undef PG8_STAGE
#undef PG8_LDA
#undef PG8_LDB
#undef PG8_MMA
#undef PG8_WAIT_V
#undef PG8_WAIT_L
#undef PG8_BAR
#undef PG8_SCHED
}

__device__ __forceinline__ u32x4 pack8(const f32x4 v0, const f32x4 v1) { u32x4 w; w.x = pk2(v0[0], v0[1]); w.y = pk2(v0[2], v0[3]); w.z = pk2(v1[0], v1[1]); w.w = pk2(v1[2], v1[3]); return w; }

struct EpiBf16 {
    static constexpr bool PERM = true;
    bf16_t* O; int ldc;
    __device__ __forceinline__ void operator()(const f32x4 (&acc)[2][2][4][2], const Unit& u, int wr, int wc, int fr, int fq) const {
        const int row0 = u.pm * BM + wr * 64 + fr, col0 = u.pn * BM + wc * 32 + 8 * fq;
#pragma unroll
        for (int ai = 0; ai < 2; ++ai)
#pragma unroll
            for (int m = 0; m < 4; ++m) { bf16_t* rowp = O + (size_t)(row0 + ai * HALF + m * 16) * ldc + col0;
#pragma unroll
                for (int bj = 0; bj < 2; ++bj) *(u32x4*)(rowp + bj * HALF) = pack8(acc[ai][bj][m][0], acc[ai][bj][m][1]); }
    }
};

struct EpiSwiglu {
    static constexpr bool PERM = true;
    bf16_t* O;
    __device__ __forceinline__ void operator()(const f32x4 (&acc)[2][2][4][2], const Unit& u, int wr, int wc, int fr, int fq) const {
        const int row0 = u.pm * BM + wr * 64 + fr, col0 = u.pn * HALF + wc * 32 + 8 * fq;
#pragma unroll
        for (int ai = 0; ai < 2; ++ai)
#pragma unroll
            for (int m = 0; m < 4; ++m) { bf16_t* rowp = O + (size_t)(row0 + ai * HALF + m * 16) * FF + col0;
                f32x4 v0, v1;
#pragma unroll
                for (int i = 0; i < 4; ++i) { const float g0 = acc[ai][0][m][0][i], g1 = acc[ai][0][m][1][i];
                    v0[i] = g0 * sigm(g0) * acc[ai][1][m][0][i]; v1[i] = g1 * sigm(g1) * acc[ai][1][m][1][i]; }
                *(u32x4*)rowp = pack8(v0, v1); }
    }
};

struct EpiGated {
    static constexpr bool PERM = true;
    const bf16_t* G; float* T; bf16_t* O; int j;
    __device__ __forceinline__ void operator()(const f32x4 (&acc)[2][2][4][2], const Unit& u, int wr, int wc, int fr, int fq) const {
        const int row0 = u.pm * BM + wr * 64 + fr, col0 = u.pn * BM + wc * 32 + 8 * fq;
#pragma unroll
        for (int ai = 0; ai < 2; ++ai)
#pragma unroll
            for (int m = 0; m < 4; ++m) { const size_t row = (size_t)(row0 + ai * HALF + m * 16);
#pragma unroll
                for (int bj = 0; bj < 2; ++bj) { const int col = col0 + bj * HALF;
                    const u32x4 gw = *(const u32x4*)(G + row * GW + j * DM + col);
                    f32x4 v0 = acc[ai][bj][m][0], v1 = acc[ai][bj][m][1];
                    v0[0] *= bflo(gw.x); v0[1] *= bfhi(gw.x); v0[2] *= bflo(gw.y); v0[3] *= bfhi(gw.y);
                    v1[0] *= bflo(gw.z); v1[1] *= bfhi(gw.z); v1[2] *= bflo(gw.w); v1[3] *= bfhi(gw.w);
                    float* tp = T + row * DM + col;
                    if (j > 0) { v0 += *(const f32x4*)tp; v1 += *(const f32x4*)(tp + 4); }
                    if (j < 2) { *(f32x4*)tp = v0; *(f32x4*)(tp + 4) = v1; }
                    else *(u32x4*)(O + row * DM + col) = pack8(v0, v1); } }
    }
};

struct EpiIn {
    static constexpr bool PERM = true;
    bf16_t* Z1; bf16_t* G; const float* bgate; float* okwin; float* ovwin; float* okrow; float* ovrow;
    __device__ __forceinline__ void operator()(const f32x4 (&acc)[2][2][4][2], const Unit& u, int wr, int wc, int fr, int fq) const {
        const int pn = u.pn, row0 = u.pm * BM + wr * 64 + fr, ct = wc * 32 + 8 * fq;
        if (pn < 15) {
            const bool gel = pn < 4; const bool kv = (pn == 7) || (pn == 8);
#pragma unroll
            for (int ai = 0; ai < 2; ++ai)
#pragma unroll
                for (int m = 0; m < 4; ++m) { const int row = row0 + ai * HALF + m * 16; bf16_t* rowp = Z1 + (size_t)row * ZW + pn * BM + ct;
                    float* dst = nullptr;
                    if (kv) { if (row < MPR) { const int s = row & (SEQ - 1); if (s >= SEQ - 2048) dst = (pn == 7 ? okwin : ovwin) + (size_t)((row >> 13) * 2048 + (s - (SEQ - 2048))) * 256; }
                              else if (row < MR) dst = (pn == 7 ? okrow : ovrow) + (size_t)(row - MPR) * 256; }
#pragma unroll
                    for (int bj = 0; bj < 2; ++bj) { f32x4 v0 = acc[ai][bj][m][0], v1 = acc[ai][bj][m][1];
                        if (gel) {
#pragma unroll
                            for (int i = 0; i < 4; ++i) { v0[i] = gelu_t(v0[i]); v1[i] = gelu_t(v1[i]); } }
                        *(u32x4*)(rowp + bj * HALF) = pack8(v0, v1);
                        if (dst) { *(f32x4*)(dst + bj * HALF + ct) = v0; *(f32x4*)(dst + bj * HALF + ct + 4) = v1; } } }
        } else {
            const int cb = (pn - 15) * BM + ct;
#pragma unroll
            for (int bj = 0; bj < 2; ++bj) { const f32x4 b0 = *(const f32x4*)(bgate + cb + bj * HALF), b1 = *(const f32x4*)(bgate + cb + bj * HALF + 4);
#pragma unroll
                for (int ai = 0; ai < 2; ++ai)
#pragma unroll
                    for (int m = 0; m < 4; ++m) { const int row = row0 + ai * HALF + m * 16; f32x4 v0 = acc[ai][bj][m][0] + b0, v1 = acc[ai][bj][m][1] + b1;
#pragma unroll
                        for (int i = 0; i < 4; ++i) { v0[i] = sigm(v0[i]); v1[i] = sigm(v1[i]); }
                        *(u32x4*)(G + (size_t)row * GW + cb + bj * HALF) = pack8(v0, v1); } }
        }
    }
};
}

struct Params { const float* in[24]; float* out; unsigned char* ws; int ph_lo, ph_hi; };

__device__ __forceinline__ void transpose_item(const float* W, int N, int k0, int n0, bf16_t* WT, int ldt, int dst_row0, int dst_col0, LAS float* scr, int lane) {
#pragma unroll 8
    for (int i = 0; i < 32; ++i) { const int kk = 2 * i + (lane >> 5); scr[kk * 33 + (lane & 31)] = W[(size_t)(k0 + kk) * N + n0 + (lane & 31)]; }
    LDS_WAIT(); asm volatile("" ::: "memory");
    const int c = lane & 7;
#pragma unroll
    for (int j = 0; j < 4; ++j) { const int n = (lane >> 3) + 8 * j; const LAS float* s = scr + (8 * c) * 33 + n;
        u32x4 o; o.x = pk2(s[0 * 33], s[1 * 33]); o.y = pk2(s[2 * 33], s[3 * 33]); o.z = pk2(s[4 * 33], s[5 * 33]); o.w = pk2(s[6 * 33], s[7 * 33]);
        *(u32x4*)(WT + (size_t)(dst_row0 + n) * ldt + dst_col0 + k0 + 8 * c) = o; }
    LDS_WAIT(); asm volatile("" ::: "memory");
}

__device__ __forceinline__ void rms_row_to_bf16(const float* xrow, const float* gain, bf16_t* orow, int lane) {
    f32x4 v[4]; float s = 0.f;
#pragma unroll
    for (int j = 0; j < 4; ++j) { v[j] = *(const f32x4*)(xrow + 4 * lane + 256 * j); s += (v[j].x * v[j].x + v[j].y * v[j].y) + (v[j].z * v[j].z + v[j].w * v[j].w); }
    const float r = 1.f / sqrtf(wave_sum(s) * (1.f / DM) + EPS);
#pragma unroll
    for (int j = 0; j < 4; ++j) { const f32x4 gg = *(const f32x4*)(gain + 4 * lane + 256 * j);
        u32x2 o; o.x = pk2(v[j].x * r * gg.x, v[j].y * r * gg.y); o.y = pk2(v[j].z * r * gg.z, v[j].w * r * gg.w);
        *(u32x2*)(orow + 4 * lane + 256 * j) = o; }
}

__device__ __forceinline__ void phase_prologue(const Params& P, LAS unsigned char* lds) {
    const int tid = opaque_tid(), lane = tid & 63, wave = tid >> 6;
    LAS float* scr = (LAS float*)(lds + wave * 16384);
    const int gw = opaque_bid() * 8 + wave, NGW = gridDim.x * 8;
    constexpr int I_IN = 16 * 216, I_BA = 8 * 32, I_BB = 4 * 32, I_BC = 8 * 32, I_O = 16 * 32, I_G = 16 * 88, I_U = 16 * 88, I_D = 44 * 32;
    constexpr int PER_LAYER = I_IN + I_BA + I_BB + I_BC + I_O + I_G + I_U + I_D;
    for (int it = gw; it < 2 * PER_LAYER; it += NGW) {
        const int l = it / PER_LAYER; int r = it % PER_LAYER;
        unsigned char* wl = P.ws + WS_W + (size_t)l * W_LAYER;
        if (r < I_IN) { const int kb = r / 216, nb = r % 216; transpose_item(P.in[9] + (size_t)l * DM * INW, INW, 64 * kb, 32 * nb, (bf16_t*)(wl + WO_IN), DM, 32 * nb, 0, scr, lane); continue; } r -= I_IN;
        if (r < I_BA) { const int kb = r / 32, nb = r % 32; transpose_item(P.in[16] + (size_t)l * 512 * DM, DM, 64 * kb, 32 * nb, (bf16_t*)(wl + WO_BR), MIXW, 32 * nb, 0, scr, lane); continue; } r -= I_BA;
        if (r < I_BB) { const int kb = r / 32, nb = r % 32; transpose_item(P.in[17] + (size_t)l * 256 * DM, DM, 64 * kb, 32 * nb, (bf16_t*)(wl + WO_BR), MIXW, 32 * nb, 512, scr, lane); continue; } r -= I_BB;
        if (r < I_BC) { const int kb = r / 32, nb = r % 32; transpose_item(P.in[18] + (size_t)l * 512 * DM, DM, 64 * kb, 32 * nb, (bf16_t*)(wl + WO_BR), MIXW, 32 * nb, 768, scr, lane); continue; } r -= I_BC;
        if (r < I_O) { const int kb = r / 32, nb = r % 32; transpose_item(P.in[20] + (size_t)l * DM * DM, DM, 64 * kb, 32 * nb, (bf16_t*)(wl + WO_O), DM, 32 * nb, 0, scr, lane); continue; } r -= I_O;
        if (r < I_G) { const int kb = r / 88, nb = r % 88; const int n0 = 32 * nb; transpose_item(P.in[21] + (size_t)l * DM * FF, FF, 64 * kb, n0, (bf16_t*)(wl + WO_GU), DM, (n0 >> 7) * 256 + (n0 & 127), 0, scr, lane); continue; } r -= I_G;
        if (r < I_U) { const int kb = r / 88, nb = r % 88; const int n0 = 32 * nb; transpose_item(P.in[22] + (size_t)l * DM * FF, FF, 64 * kb, n0, (bf16_t*)(wl + WO_GU), DM, (n0 >> 7) * 256 + (n0 & 127) + 128, 0, scr, lane); continue; } r -= I_U;
        { const int kb = r / 32, nb = r % 32; transpose_item(P.in[23] + (size_t)l * FF * DM, DM, 64 * kb, 32 * nb, (bf16_t*)(wl + WO_D), FF, 32 * nb, 0, scr, lane); }
    }
    bf16_t* H = (bf16_t*)(P.ws + WS_R1);
    for (int m = gw; m < MR; m += NGW) {
        const float* xr = m < MPR ? P.in[0] + (size_t)m * DM : P.in[1] + (size_t)(m - MPR) * DM;
        rms_row_to_bf16(xr, P.in[5], H + (size_t)m * DM, lane);
    }
}

__device__ __forceinline__ float alibi_slope(int i) { return exp2f(-8.0f * (float)(i + 1) / 12.0f); }

constexpr int KS_PITCH = 72, VT_PITCH = 264;
constexpr int ATT_KS = 0, ATT_VT = 256 * KS_PITCH * 2;
__device__ __forceinline__ void attn_prompt_unit(const Params& P, LAS unsigned char* lds, int b, int g, int tile, int h) {
    const int tid = opaque_tid(), lane = tid & 63, w = tid >> 6, fr = lane & 15, fq = lane >> 4;
    const int sh = 2 * g, dil = 1 << sh;
    const int r = tile & (dil - 1), n = tile >> sh;
    const bf16_t* Z1 = (const bf16_t*)(P.ws + WS_Z1);
    LAS bf16_t* Ks = (LAS bf16_t*)(lds + ATT_KS);
    LAS bf16_t* Vt = (LAS bf16_t*)(lds + ATT_VT);
#pragma unroll
    for (int i = 0; i < 4; ++i) {
        const int c = tid + 512 * i, key = c >> 3, part = c & 7;
        const int jp = 128 * (n - 1) + key;
        u32x4 kk = (u32x4){0u, 0u, 0u, 0u}, vv = (u32x4){0u, 0u, 0u, 0u};
        if (jp >= 0) { const bf16_t* rp = Z1 + (size_t)(b * SEQ + jp * dil + r) * ZW + h * 64 + 8 * part;
            kk = *(const u32x4*)(rp + ZC_K); vv = *(const u32x4*)(rp + ZC_V); }
        *(LAS u32x4*)(Ks + key * KS_PITCH + 8 * part) = kk;
        LAS bf16_t* vp = Vt + (8 * part) * VT_PITCH + key;
        vp[0 * VT_PITCH] = (bf16_t)(vv.x & 0xffffu); vp[1 * VT_PITCH] = (bf16_t)(vv.x >> 16);
        vp[2 * VT_PITCH] = (bf16_t)(vv.y & 0xffffu); vp[3 * VT_PITCH] = (bf16_t)(vv.y >> 16);
        vp[4 * VT_PITCH] = (bf16_t)(vv.z & 0xffffu); vp[5 * VT_PITCH] = (bf16_t)(vv.z >> 16);
        vp[6 * VT_PITCH] = (bf16_t)(vv.w & 0xffffu); vp[7 * VT_PITCH] = (bf16_t)(vv.w >> 16);
    }
    const int q = 16 * w + fr;
    const size_t qrow = (size_t)(b * SEQ + (128 * n + q) * dil + r);
    bf16x8 qf[2];
    { const bf16_t* qp = Z1 + qrow * ZW + ZC_Q + (g * 4 + h) * 64 + 8 * fq; qf[0] = *(const bf16x8*)qp; qf[1] = *(const bf16x8*)(qp + 32); }
    __syncthreads();
    const float sl = alibi_slope(g * 4 + h) * (float)dil;
    f32x4 sc[9];
    float mx = -INFINITY;
#pragma unroll
    for (int kb = 0; kb < 9; ++kb) {
        const LAS bf16_t* kp = Ks + (16 * (w + kb) + fr) * KS_PITCH + 8 * fq;
        f32x4 a = (f32x4){0.f, 0.f, 0.f, 0.f};
        a = __builtin_amdgcn_mfma_f32_16x16x32_bf16(*(const LAS bf16x8*)kp, qf[0], a, 0, 0, 0);
        a = __builtin_amdgcn_mfma_f32_16x16x32_bf16(*(const LAS bf16x8*)(kp + 32), qf[1], a, 0, 0, 0);
#pragma unroll
        for (int i = 0; i < 4; ++i) {
            const int dist = fr + 128 - 16 * kb - 4 * fq - i;
            const int kidx = 16 * (w + kb) + 4 * fq + i;
            const bool valid = (dist >= 0) && (dist <= 128) && (n > 0 || kidx >= 128);
            const float s = valid ? a[i] * 0.125f - sl * (float)dist : -INFINITY;
            a[i] = s; mx = fmaxf(mx, s);
        }
        sc[kb] = a;
    }
    mx = fmaxf(mx, __shfl_xor(mx, 16)); mx = fmaxf(mx, __shfl_xor(mx, 32));
    float den = 0.f;
    f32x4 o[4];
#pragma unroll
    for (int d = 0; d < 4; ++d) o[d] = (f32x4){0.f, 0.f, 0.f, 0.f};
#pragma unroll
    for (int kb = 0; kb < 9; ++kb) {
        f32x4 p;
#pragma unroll
        for (int i = 0; i < 4; ++i) { p[i] = __expf(sc[kb][i] - mx); den += p[i]; }
        u32x2 pw; pw.x = pk2(p[0], p[1]); pw.y = pk2(p[2], p[3]);
        const bf16x4 pf = __builtin_bit_cast(bf16x4, pw);
#pragma unroll
        for (int d = 0; d < 4; ++d) {
            const bf16x4 vf = *(const LAS bf16x4*)(Vt + (16 * d + fr) * VT_PITCH + 16 * (w + kb) + 4 * fq);
            o[d] = __builtin_amdgcn_mfma_f32_16x16x16bf16_1k(vf, pf, o[d], 0, 0, 0);
        }
    }
    den += __shfl_xor(den, 16); den += __shfl_xor(den, 32);
    const float rden = 1.f / den;
    bf16_t* og = (bf16_t*)(P.ws + WS_R3) + ((size_t)g * MPR + qrow) * 256 + h * 64 + 4 * fq;
#pragma unroll
    for (int d = 0; d < 4; ++d) { u32x2 ow; ow.x = pk2(o[d][0] * rden, o[d][1] * rden); ow.y = pk2(o[d][2] * rden, o[d][3] * rden); *(u32x2*)(og + 16 * d) = ow; }
    if (fq == 0) { float* lse = (float*)(P.ws + WS_R3 + R3_LSE); lse[((size_t)g * MPR + qrow) * 4 + h] = mx + __logf(den); }
    __syncthreads();
}

__device__ __forceinline__ void attn_sample_unit(const Params& P, LAS unsigned char* lds, int l, int db, int t) {
    const int tid = opaque_tid(), lane = tid & 63, w = tid >> 6, h = lane >> 4, dq = (lane & 15) * 4;
    LAS float* scs = (LAS float*)lds;
    LAS float* red = (LAS float*)(lds + 4096);
    const bf16_t* Z1 = (const bf16_t*)(P.ws + WS_Z1);
    const size_t row = (size_t)(MPR + db * 4 + t);
    const float* ck = P.in[2] + ((size_t)(l * 32 + db) * 2048) * 256;
    const float* cv = P.in[3] + ((size_t)(l * 32 + db) * 2048) * 256;
    const float* nk = P.out + O_KROW + ((size_t)(l * 128 + db * 4)) * 256;
    const float* nv = P.out + O_VROW + ((size_t)(l * 128 + db * 4)) * 256;
    f32x4 accn = (f32x4){0.f, 0.f, 0.f, 0.f}; float Mrun = -INFINITY, Lrun = 0.f;
    for (int g = 0; g < 3; ++g) {
        const int dil = 1 << (2 * g);
        const float sl = alibi_slope(g * 4 + h) * (float)dil;
        f32x4 q4;
        { const u32x2 qw = *(const u32x2*)(Z1 + row * ZW + ZC_Q + (g * 4 + h) * 64 + dq); q4 = (f32x4){bflo(qw.x), bfhi(qw.x), bflo(qw.y), bfhi(qw.y)} * 0.125f; }
        for (int j = w; j < 129; j += 8) {
            const int idx = 2048 + t - dil * j;
            const float* kp = idx < 2048 ? ck + (size_t)idx * 256 : nk + (size_t)(idx - 2048) * 256;
            const f32x4 k4 = *(const f32x4*)(kp + h * 64 + dq);
            float d = (q4.x * k4.x + q4.y * k4.y) + (q4.z * k4.z + q4.w * k4.w);
            d += __shfl_xor(d, 1); d += __shfl_xor(d, 2); d += __shfl_xor(d, 4); d += __shfl_xor(d, 8);
            if ((lane & 15) == 0) scs[j * 4 + h] = d - sl * (float)j;
        }
        __syncthreads();
        float mg = -INFINITY;
        for (int j = 0; j < 129; ++j) mg = fmaxf(mg, scs[j * 4 + h]);
        float dg = 0.f;
        for (int j = 0; j < 129; ++j) dg += __expf(scs[j * 4 + h] - mg);
        f32x4 o4 = (f32x4){0.f, 0.f, 0.f, 0.f};
        for (int j = w; j < 129; j += 8) {
            const int idx = 2048 + t - dil * j;
            const float* vp = idx < 2048 ? cv + (size_t)idx * 256 : nv + (size_t)(idx - 2048) * 256;
            const f32x4 v4 = *(const f32x4*)(vp + h * 64 + dq);
            const float p = __expf(scs[j * 4 + h] - mg);
            o4 += v4 * p;
        }
        *(LAS f32x4*)(red + w * 256 + lane * 4) = o4;
        __syncthreads();
        if (w == 0) {
            f32x4 s = (f32x4){0.f, 0.f, 0.f, 0.f};
#pragma unroll
            for (int ww = 0; ww < 8; ++ww) s += *(const LAS f32x4*)(red + ww * 256 + lane * 4);
            const float nm = fmaxf(Mrun, mg); const float fa = __expf(Mrun - nm), fb = __expf(mg - nm);
            accn = accn * fa + s * fb; Lrun = Lrun * fa + dg * fb; Mrun = nm;
        }
        __syncthreads();
    }
    if (w == 0) {
        const float rl = 1.f / Lrun;
        u32x2 ow; ow.x = pk2(accn.x * rl, accn.y * rl); ow.y = pk2(accn.z * rl, accn.w * rl);
        *(u32x2*)((bf16_t*)(P.ws + WS_R1) + row * MIXW + 512 + h * 64 + dq) = ow;
    }
}

constexpr int GP = 136;
__device__ __forceinline__ void gate_prompt_unit(const Params& P, LAS unsigned char* lds, int l, int chunk, int g) {
    const int tid = opaque_tid(), lane = tid & 63, w = tid >> 6, fr = lane & 15, fq = lane >> 4;
    LAS bf16_t* Wt = (LAS bf16_t*)lds;
    LAS bf16_t* VnT = (LAS bf16_t*)(lds + 128 * GP * 2);
    LAS float* st = (LAS float*)(lds + 2 * 128 * GP * 2);
    const bf16_t* Z1 = (const bf16_t*)(P.ws + WS_Z1);
    const size_t row0 = (size_t)chunk * 128;
    for (int i = 0; i < 16; ++i) {
        const int rr = 16 * w + i;
        const u32x4 x = *(const u32x4*)(Z1 + (row0 + rr) * ZW + ZC_GV + 8 * lane);
        float v[8] = {bflo(x.x), bfhi(x.x), bflo(x.y), bfhi(x.y), bflo(x.z), bfhi(x.z), bflo(x.w), bfhi(x.w)};
        float s = 0.f;
#pragma unroll
        for (int e = 0; e < 8; ++e) s += v[e];
        const float mean = wave_sum(s) * (1.f / 512.f);
        float s2 = 0.f;
#pragma unroll
        for (int e = 0; e < 8; ++e) { const float d = v[e] - mean; s2 += d * d; }
        const float rstd = 1.f / sqrtf(wave_sum(s2) * (1.f / 512.f) + EPS);
        if (lane == 0) { st[2 * rr] = mean; st[2 * rr + 1] = rstd; }
    }
    const float* Wsrc = P.in[12] + (size_t)(l * 4 + g) * 128 * 128;
#pragma unroll
    for (int i = 0; i < 8; ++i) {
        const int e = (tid + 512 * i) * 4, tt = e >> 7, ss = e & 127;
        const f32x4 x = *(const f32x4*)(Wsrc + e);
        u32x2 o; o.x = pk2(ss <= tt ? x.x : 0.f, ss + 1 <= tt ? x.y : 0.f); o.y = pk2(ss + 2 <= tt ? x.z : 0.f, ss + 3 <= tt ? x.w : 0.f);
        *(LAS u32x2*)(Wt + tt * GP + ss) = o;
    }
    __syncthreads();
    const float* lng = P.in[10] + l * 512 + g * 128; const float* lnb = P.in[11] + l * 512 + g * 128;
#pragma unroll
    for (int i = 0; i < 4; ++i) {
        const int item = tid + 512 * i, ss = item >> 4, oc = item & 15;
        const u32x4 x = *(const u32x4*)(Z1 + (row0 + ss) * ZW + ZC_GV + g * 128 + 8 * oc);
        const float mean = st[2 * ss], rstd = st[2 * ss + 1];
        float v[8] = {bflo(x.x), bfhi(x.x), bflo(x.y), bfhi(x.y), bflo(x.z), bfhi(x.z), bflo(x.w), bfhi(x.w)};
#pragma unroll
        for (int e = 0; e < 8; ++e) { const float y = (v[e] - mean) * rstd * lng[8 * oc + e] + lnb[8 * oc + e]; VnT[(8 * oc + e) * GP + ss] = (bf16_t)f2bf(y); }
    }
    __syncthreads();
    f32x4 acc[8];
#pragma unroll
    for (int cb = 0; cb < 8; ++cb) acc[cb] = (f32x4){0.f, 0.f, 0.f, 0.f};
#pragma unroll
    for (int ks = 0; ks < 4; ++ks) {
        const bf16x8 af = *(const LAS bf16x8*)(Wt + (16 * w + fr) * GP + 32 * ks + 8 * fq);
#pragma unroll
        for (int cb = 0; cb < 8; ++cb) {
            const bf16x8 bfv = *(const LAS bf16x8*)(VnT + (16 * cb + fr) * GP + 32 * ks + 8 * fq);
            acc[cb] = __builtin_amdgcn_mfma_f32_16x16x32_bf16(bfv, af, acc[cb], 0, 0, 0);
        }
    }
    const int tt = 16 * w + fr;
    const float bs = P.in[13][(size_t)(l * 4 + g) * 128 + tt];
    const bf16_t* up = Z1 + (row0 + tt) * ZW + ZC_U + g * 128 + 4 * fq;
    bf16_t* op = (bf16_t*)(P.ws + WS_R1) + (row0 + tt) * MIXW + g * 128 + 4 * fq;
#pragma unroll
    for (int cb = 0; cb < 8; ++cb) {
        const u32x2 uw = *(const u32x2*)(up + 16 * cb);
        u32x2 ow; ow.x = pk2(bflo(uw.x) * (acc[cb][0] + bs), bfhi(uw.x) * (acc[cb][1] + bs)); ow.y = pk2(bflo(uw.y) * (acc[cb][2] + bs), bfhi(uw.y) * (acc[cb][3] + bs));
        *(u32x2*)(op + 16 * cb) = ow;
    }
    __syncthreads();
}

__device__ __forceinline__ void sample_gc_unit(const Params& P, LAS unsigned char* lds, int l, int db) {
    const int tid = opaque_tid(), lane = tid & 63, w = tid >> 6;
    LAS float* st = (LAS float*)lds;
    const bf16_t* Z1 = (const bf16_t*)(P.ws + WS_Z1);
    const size_t row0 = (size_t)(MPR + db * 4);
    if (w < 4) {
        const u32x4 x = *(const u32x4*)(Z1 + (row0 + w) * ZW + ZC_GV + 8 * lane);
        float v[8] = {bflo(x.x), bfhi(x.x), bflo(x.y), bfhi(x.y), bflo(x.z), bfhi(x.z), bflo(x.w), bfhi(x.w)};
        float s = 0.f;
#pragma unroll
        for (int e = 0; e < 8; ++e) s += v[e];
        const float mean = wave_sum(s) * (1.f / 512.f);
        float s2 = 0.f;
#pragma unroll
        for (int e = 0; e < 8; ++e) { const float d = v[e] - mean; s2 += d * d; }
        const float rstd = 1.f / sqrtf(wave_sum(s2) * (1.f / 512.f) + EPS);
        if (lane == 0) { st[2 * w] = mean; st[2 * w + 1] = rstd; }
    }
    __syncthreads();
    const int c = tid, g = c >> 7, cc = c & 127;
    bf16_t* MIX = (bf16_t*)(P.ws + WS_R1);
    {
        const float lg = P.in[10][l * 512 + c], lb = P.in[11][l * 512 + c];
        float vn[4];
#pragma unroll
        for (int s = 0; s < 4; ++s) { vn[s] = (bf1(Z1[(row0 + s) * ZW + ZC_GV + c]) - st[2 * s]) * st[2 * s + 1] * lg + lb;
            P.out[O_AV + ((size_t)(l * 128 + db * 4 + s)) * 512 + c] = vn[s]; }
        const float* Wsrc = P.in[12] + (size_t)(l * 4 + g) * 128 * 128;
#pragma unroll
        for (int t = 0; t < 4; ++t) { float sa = P.in[13][(size_t)(l * 4 + g) * 128 + t];
#pragma unroll
            for (int s = 0; s < 4; ++s) if (s <= t) sa += Wsrc[t * 128 + s] * vn[s];
            MIX[(row0 + t) * MIXW + c] = (bf16_t)f2bf(bf1(Z1[(row0 + t) * ZW + ZC_U + c]) * sa); }
        (void)cc;
    }
    {
        float zp[6];
        zp[0] = P.in[4][((size_t)(l * 32 + db) * 2 + 0) * 512 + c]; zp[1] = P.in[4][((size_t)(l * 32 + db) * 2 + 1) * 512 + c];
#pragma unroll
        for (int t = 0; t < 4; ++t) zp[2 + t] = bf1(Z1[(row0 + t) * ZW + ZC_CC + c]) * bf1(Z1[(row0 + t) * ZW + ZC_CX + c]);
        const float w0 = P.in[14][(size_t)(l * 3 + 0) * 512 + c], w1 = P.in[14][(size_t)(l * 3 + 1) * 512 + c], w2 = P.in[14][(size_t)(l * 3 + 2) * 512 + c], cbias = P.in[15][l * 512 + c];
#pragma unroll
        for (int t = 0; t < 4; ++t) { const float conv = cbias + w0 * zp[t] + w1 * zp[t + 1] + w2 * zp[t + 2];
            MIX[(row0 + t) * MIXW + 768 + c] = (bf16_t)f2bf(bf1(Z1[(row0 + t) * ZW + ZC_CB + c]) * conv); }
        P.out[O_CONVS + ((size_t)(l * 32 + db) * 2 + 0) * 512 + c] = zp[4];
        P.out[O_CONVS + ((size_t)(l * 32 + db) * 2 + 1) * 512 + c] = zp[5];
    }
    __syncthreads();
}

__device__ __forceinline__ void conv_prompt_unit(const Params& P, int l, int rb) {
    const int tid = opaque_tid(), oc = tid & 63, rs = tid >> 6;
    const bf16_t* Z1 = (const bf16_t*)(P.ws + WS_Z1);
    bf16_t* MIX = (bf16_t*)(P.ws + WS_R1);
    const size_t row0 = (size_t)rb * 64 + rs * 8;
    const int s0 = (int)(row0 & (SEQ - 1)), bb = (int)(row0 >> 13);
    float w0[8], w1[8], w2[8], cbias[8], zm2[8], zm1[8];
#pragma unroll
    for (int e = 0; e < 8; ++e) { w0[e] = P.in[14][(size_t)(l * 3 + 0) * 512 + 8 * oc + e]; w1[e] = P.in[14][(size_t)(l * 3 + 1) * 512 + 8 * oc + e]; w2[e] = P.in[14][(size_t)(l * 3 + 2) * 512 + 8 * oc + e]; cbias[e] = P.in[15][l * 512 + 8 * oc + e]; zm2[e] = 0.f; zm1[e] = 0.f; }
    if (s0 >= 2) {
        const u32x4 a2 = *(const u32x4*)(Z1 + (row0 - 2) * ZW + ZC_CC + 8 * oc), b2 = *(const u32x4*)(Z1 + (row0 - 2) * ZW + ZC_CX + 8 * oc);
        const u32x4 a1 = *(const u32x4*)(Z1 + (row0 - 1) * ZW + ZC_CC + 8 * oc), b1 = *(const u32x4*)(Z1 + (row0 - 1) * ZW + ZC_CX + 8 * oc);
        zm2[0] = bflo(a2.x) * bflo(b2.x); zm2[1] = bfhi(a2.x) * bfhi(b2.x); zm2[2] = bflo(a2.y) * bflo(b2.y); zm2[3] = bfhi(a2.y) * bfhi(b2.y);
        zm2[4] = bflo(a2.z) * bflo(b2.z); zm2[5] = bfhi(a2.z) * bfhi(b2.z); zm2[6] = bflo(a2.w) * bflo(b2.w); zm2[7] = bfhi(a2.w) * bfhi(b2.w);
        zm1[0] = bflo(a1.x) * bflo(b1.x); zm1[1] = bfhi(a1.x) * bfhi(b1.x); zm1[2] = bflo(a1.y) * bflo(b1.y); zm1[3] = bfhi(a1.y) * bfhi(b1.y);
        zm1[4] = bflo(a1.z) * bflo(b1.z); zm1[5] = bfhi(a1.z) * bfhi(b1.z); zm1[6] = bflo(a1.w) * bflo(b1.w); zm1[7] = bfhi(a1.w) * bfhi(b1.w);
    }
    for (int i = 0; i < 8; ++i) {
        const size_t row = row0 + i;
        const u32x4 a = *(const u32x4*)(Z1 + row * ZW + ZC_CC + 8 * oc), b = *(const u32x4*)(Z1 + row * ZW + ZC_CX + 8 * oc), cbv = *(const u32x4*)(Z1 + row * ZW + ZC_CB + 8 * oc);
        float z[8] = {bflo(a.x) * bflo(b.x), bfhi(a.x) * bfhi(b.x), bflo(a.y) * bflo(b.y), bfhi(a.y) * bfhi(b.y), bflo(a.z) * bflo(b.z), bfhi(a.z) * bfhi(b.z), bflo(a.w) * bflo(b.w), bfhi(a.w) * bfhi(b.w)};
        float cbf[8] = {bflo(cbv.x), bfhi(cbv.x), bflo(cbv.y), bfhi(cbv.y), bflo(cbv.z), bfhi(cbv.z), bflo(cbv.w), bfhi(cbv.w)};
        float oo[8];
#pragma unroll
        for (int e = 0; e < 8; ++e) { oo[e] = cbf[e] * (cbias[e] + w0[e] * zm2[e] + w1[e] * zm1[e] + w2[e] * z[e]); zm2[e] = zm1[e]; zm1[e] = z[e]; }
        u32x4 ow; ow.x = pk2(oo[0], oo[1]); ow.y = pk2(oo[2], oo[3]); ow.z = pk2(oo[4], oo[5]); ow.w = pk2(oo[6], oo[7]);
        *(u32x4*)(MIX + row * MIXW + 768 + 8 * oc) = ow;
        const int s = s0 + i;
        if (s >= SEQ - 2) { float* dst = P.out + O_CONVP + ((size_t)(l * 2 + bb) * 2 + (s - (SEQ - 2))) * 512 + 8 * oc;
            *(f32x4*)dst = (f32x4){z[0], z[1], z[2], z[3]}; *(f32x4*)(dst + 4) = (f32x4){z[4], z[5], z[6], z[7]}; }
    }
}

__device__ __forceinline__ void phase_mixer(const Params& P, LAS unsigned char* lds, int l) {
    constexpr int N_SA = 128, N_SG = 32, N_G = 512, N_A = 1536, N_C = 256, N_ALL = N_SA + N_SG + N_G + N_A + N_C;
    for (int u = opaque_bid(); u < N_ALL; u += gridDim.x) {
        int r = u;
        if (r < N_SA) { attn_sample_unit(P, lds, l, r >> 2, r & 3); continue; } r -= N_SA;
        if (r < N_SG) { sample_gc_unit(P, lds, l, r); continue; } r -= N_SG;
        if (r < N_G) { gate_prompt_unit(P, lds, l, r >> 2, r & 3); continue; } r -= N_G;
        if (r < N_A) { const int h = r & 3, tile = (r >> 2) & 63, bg = r >> 8; attn_prompt_unit(P, lds, bg & 1, bg >> 1, tile, h); continue; } r -= N_A;
        conv_prompt_unit(P, l, r);
    }
}

__device__ __forceinline__ void phase_combine(const Params& P) {
    const bf16_t* og = (const bf16_t*)(P.ws + WS_R3); const float* lse = (const float*)(P.ws + WS_R3 + R3_LSE);
    bf16_t* MIX = (bf16_t*)(P.ws + WS_R1);
    const int nth = gridDim.x * 512;
    for (int idx = opaque_bid() * 512 + opaque_tid(); idx < MPR * 32; idx += nth) {
        const int part = idx & 7, h = (idx >> 3) & 3; const size_t row = (size_t)(idx >> 5);
        const float l0 = lse[(0 * (size_t)MPR + row) * 4 + h], l1 = lse[(1 * (size_t)MPR + row) * 4 + h], l2 = lse[(2 * (size_t)MPR + row) * 4 + h];
        const float m = fmaxf(l0, fmaxf(l1, l2));
        float w0 = __expf(l0 - m), w1 = __expf(l1 - m), w2 = __expf(l2 - m); const float rs = 1.f / (w0 + w1 + w2); w0 *= rs; w1 *= rs; w2 *= rs;
        const u32x4 a = *(const u32x4*)(og + (0 * (size_t)MPR + row) * 256 + h * 64 + 8 * part);
        const u32x4 b = *(const u32x4*)(og + (1 * (size_t)MPR + row) * 256 + h * 64 + 8 * part);
        const u32x4 c = *(const u32x4*)(og + (2 * (size_t)MPR + row) * 256 + h * 64 + 8 * part);
        u32x4 o;
        o.x = pk2(w0 * bflo(a.x) + w1 * bflo(b.x) + w2 * bflo(c.x), w0 * bfhi(a.x) + w1 * bfhi(b.x) + w2 * bfhi(c.x));
        o.y = pk2(w0 * bflo(a.y) + w1 * bflo(b.y) + w2 * bflo(c.y), w0 * bfhi(a.y) + w1 * bfhi(b.y) + w2 * bfhi(c.y));
        o.z = pk2(w0 * bflo(a.z) + w1 * bflo(b.z) + w2 * bflo(c.z), w0 * bfhi(a.z) + w1 * bfhi(b.z) + w2 * bfhi(c.z));
        o.w = pk2(w0 * bflo(a.w) + w1 * bflo(b.w) + w2 * bflo(c.w), w0 * bfhi(a.w) + w1 * bfhi(b.w) + w2 * bfhi(c.w));
        *(u32x4*)(MIX + row * MIXW + 512 + h * 64 + 8 * part) = o;
    }
}

__device__ __forceinline__ void phase_rows(const Params& P, const bf16_t* src, bool x_from_input, const float* gpost, const float* gnext) {
    const int tid = opaque_tid(), lane = tid & 63, wave = tid >> 6;
    const int gw = opaque_bid() * 8 + wave, NGW = gridDim.x * 8;
    bf16_t* H = (bf16_t*)(P.ws + WS_R1);
    for (int m = gw; m < MR; m += NGW) {
        const float* xr = x_from_input ? (m < MPR ? P.in[0] + (size_t)m * DM : P.in[1] + (size_t)(m - MPR) * DM) : P.out + (size_t)m * DM;
        float* xo = P.out + (size_t)m * DM;
        f32x4 mv[4], xv[4]; float s = 0.f;
#pragma unroll
        for (int j = 0; j < 4; ++j) { const u32x2 mw = *(const u32x2*)(src + (size_t)m * DM + 4 * lane + 256 * j); mv[j] = (f32x4){bflo(mw.x), bfhi(mw.x), bflo(mw.y), bfhi(mw.y)};
            xv[j] = *(const f32x4*)(xr + 4 * lane + 256 * j); s += (mv[j].x * mv[j].x + mv[j].y * mv[j].y) + (mv[j].z * mv[j].z + mv[j].w * mv[j].w); }
        const float r = 1.f / sqrtf(wave_sum(s) * (1.f / DM) + EPS);
        float s2 = 0.f;
#pragma unroll
        for (int j = 0; j < 4; ++j) { const f32x4 gg = *(const f32x4*)(gpost + 4 * lane + 256 * j); xv[j] = xv[j] + mv[j] * r * gg; *(f32x4*)(xo + 4 * lane + 256 * j) = xv[j];
            s2 += (xv[j].x * xv[j].x + xv[j].y * xv[j].y) + (xv[j].z * xv[j].z + xv[j].w * xv[j].w); }
        if (gnext) {
            const float r2 = 1.f / sqrtf(wave_sum(s2) * (1.f / DM) + EPS);
#pragma unroll
            for (int j = 0; j < 4; ++j) { const f32x4 gg = *(const f32x4*)(gnext + 4 * lane + 256 * j);
                u32x2 o; o.x = pk2(xv[j].x * r2 * gg.x, xv[j].y * r2 * gg.y); o.y = pk2(xv[j].z * r2 * gg.z, xv[j].w * r2 * gg.w);
                *(u32x2*)(H + (size_t)m * DM + 4 * lane + 256 * j) = o; }
        }
    }
}

constexpr int PH_PER_LAYER = 9, N_PHASES = 1 + 2 * PH_PER_LAYER;
template <int PH> __device__ __forceinline__ void do_phase(const Params& P, LAS unsigned char* lds) {
    if constexpr (PH == 0) { phase_prologue(P, lds); }
    else {
        constexpr int l = (PH - 1) / PH_PER_LAYER, k = (PH - 1) % PH_PER_LAYER;
        const int G = gridDim.x;
        unsigned char* wl = P.ws + WS_W + (size_t)l * W_LAYER;
        bf16_t* R1 = (bf16_t*)(P.ws + WS_R1); bf16_t* R2 = (bf16_t*)(P.ws + WS_R2); bf16_t* R3 = (bf16_t*)(P.ws + WS_R3);
        bf16_t* Z1 = (bf16_t*)(P.ws + WS_Z1); bf16_t* GB = (bf16_t*)(P.ws + WS_G);
        pg8::StaticOrder S;
        if constexpr (k == 0) {
            pg8::Gemm g{R1, (const bf16_t*)(wl + WO_IN)}; S.init(MPAD, INW, G, opaque_bid());
            pg8::EpiIn E{Z1, GB, P.in[19] + (size_t)l * GW, P.out + O_KWIN + (size_t)l * 1048576, P.out + O_VWIN + (size_t)l * 1048576, P.out + O_KROW + (size_t)l * 32768, P.out + O_VROW + (size_t)l * 32768};
            pg8::gemm_phase<pg8::EpiIn, true, DM, DM, DM>(lds, g, S, E);
        } else if constexpr (k == 1) { phase_mixer(P, lds, l); }
        else if constexpr (k == 2) { phase_combine(P); }
        else if constexpr (k == 3) {
            { S.init(MPAD, DM, G, opaque_bid()); pg8::Gemm g{R1, (const bf16_t*)(wl + WO_BR)}; pg8::EpiGated E{GB, (float*)(P.ws + WS_Z1), R2, 0}; pg8::gemm_phase<pg8::EpiGated, true, 512, MIXW, MIXW>(lds, g, S, E); }
            { S.init(MPAD, DM, G, opaque_bid()); pg8::Gemm g{R1 + 512, (const bf16_t*)(wl + WO_BR) + 512}; pg8::EpiGated E{GB, (float*)(P.ws + WS_Z1), R2, 1}; pg8::gemm_phase<pg8::EpiGated, true, 256, MIXW, MIXW>(lds, g, S, E); }
            { S.init(MPAD, DM, G, opaque_bid()); pg8::Gemm g{R1 + 768, (const bf16_t*)(wl + WO_BR) + 768}; pg8::EpiGated E{GB, (float*)(P.ws + WS_Z1), R2, 2}; pg8::gemm_phase<pg8::EpiGated, true, 512, MIXW, MIXW>(lds, g, S, E); }
        } else if constexpr (k == 4) {
            pg8::Gemm g{R2, (const bf16_t*)(wl + WO_O)}; S.init(MPAD, DM, G, opaque_bid());
            pg8::EpiBf16 E{R3, DM};
            pg8::gemm_phase<pg8::EpiBf16, true, DM, DM, DM>(lds, g, S, E);
        } else if constexpr (k == 5) { phase_rows(P, R3, l == 0, P.in[6] + (size_t)l * DM, P.in[7] + (size_t)l * DM); }
        else if constexpr (k == 6) {
            pg8::Gemm g{R1, (const bf16_t*)(wl + WO_GU)}; S.init(MPAD, 2 * FF, G, opaque_bid());
            pg8::EpiSwiglu E{Z1};
            pg8::gemm_phase<pg8::EpiSwiglu, true, DM, DM, DM>(lds, g, S, E);
        } else if constexpr (k == 7) {
            pg8::Gemm g{Z1, (const bf16_t*)(wl + WO_D)}; S.init(MPAD, DM, G, opaque_bid());
            pg8::EpiBf16 E{R2, DM};
            pg8::gemm_phase<pg8::EpiBf16, true, FF, FF, FF>(lds, g, S, E);
        } else { phase_rows(P, R2, false, P.in[8] + (size_t)l * DM, l + 1 < 2 ? P.in[5] + (size_t)(l + 1) * DM : nullptr); }
    }
    __syncthreads();
}

#ifndef PH_MASK
#define PH_MASK 0x7ffff
#endif
__global__ void __launch_bounds__(512, 2) fwd_kernel(Params P) {
    extern __shared__ __attribute__((aligned(16))) unsigned char lds_raw[];
    LAS unsigned char* lds = (LAS unsigned char*)lds_raw;
    cg::grid_group grid = cg::this_grid();
#define RUN(ph) if (((PH_MASK >> ph) & 1) && P.ph_lo <= ph && ph < P.ph_hi) { if (ph > P.ph_lo) grid.sync(); do_phase<ph>(P, lds); }
    RUN(0) RUN(1) RUN(2) RUN(3) RUN(4) RUN(5) RUN(6) RUN(7) RUN(8) RUN(9) RUN(10) RUN(11) RUN(12) RUN(13) RUN(14) RUN(15) RUN(16) RUN(17) RUN(18)
#undef RUN
}

extern "C" void kernel_launch(void* const* d_in, const int* in_sizes, int n_in, void* d_out, int out_size, void* d_ws, size_t ws_size, hipStream_t stream) {
    static int grid = 0;
    if (grid == 0) {
        int dev = 0, cus = 0, per_cu = 0;
        (void)hipGetDevice(&dev);
        (void)hipDeviceGetAttribute(&cus, hipDeviceAttributeMultiprocessorCount, dev);
        (void)hipFuncSetAttribute((const void*)fwd_kernel, hipFuncAttributeMaxDynamicSharedMemorySize, LDS_BYTES);
        (void)hipOccupancyMaxActiveBlocksPerMultiprocessor(&per_cu, (const void*)fwd_kernel, 512, LDS_BYTES);
        if (per_cu < 1) per_cu = 1;
        (void)hipGetLastError();
        grid = cus * 1;
        if (n_in != 24 || ws_size < WS_END) { fprintf(stderr, "kernel_launch: unexpected n_in %d / ws_size %zu\n", n_in, ws_size); }
    }
    Params p{};
    for (int i = 0; i < 24; ++i) p.in[i] = (const float*)d_in[i];
    p.out = (float*)d_out; p.ws = (unsigned char*)d_ws;
#if ONE_LAUNCH
    p.ph_lo = 0; p.ph_hi = N_PHASES;
    void* args[] = {&p};
    hipError_t e = hipLaunchCooperativeKernel((const void*)fwd_kernel, dim3(grid), dim3(512), args, LDS_BYTES, stream);
    if (e != hipSuccess) fprintf(stderr, "cooperative launch failed: %s (grid %d)\n", hipGetErrorString(e), grid);
#else
    for (int ph = 0; ph < N_PHASES; ++ph) {
        p.ph_lo = ph; p.ph_hi = ph + 1;
        hipLaunchKernelGGL(fwd_kernel, dim3(grid), dim3(512), LDS_BYTES, stream, p);
    }
#endif
}
```

```cpp
#include <hip/hip_runtime.h>
#include <hip/hip_cooperative_groups.h>
#include <cstdio>
#include <cstdint>
namespace cg = cooperative_groups;

#ifndef ONE_LAUNCH
#define ONE_LAUNCH 1
#endif

#define LAS __attribute__((address_space(3)))
typedef unsigned short bf16_t;
typedef short bf16x8 __attribute__((ext_vector_type(8)));
typedef short bf16x4 __attribute__((ext_vector_type(4)));
typedef float f32x4 __attribute__((ext_vector_type(4)));
typedef float f32x2 __attribute__((ext_vector_type(2)));
typedef unsigned u32x4 __attribute__((ext_vector_type(4)));
typedef unsigned u32x2 __attribute__((ext_vector_type(2)));

constexpr int DM = 1024, SEQ = 8192, MPR = 16384, MSM = 128, MR = MPR + MSM, MPAD = 16640;
constexpr int INW = 6912, ZW = 3840, GW = 3072, FF = 2816, MIXW = 1280;
constexpr size_t ZB_U = 0, ZB_GV = (size_t)MPAD * 512, ZB_Q = (size_t)MPAD * 1024, ZB_K = (size_t)MPAD * 1792, ZB_V = (size_t)MPAD * 2048, ZB_CX = (size_t)MPAD * 2304, ZB_CB = (size_t)MPAD * 2816, ZB_CC = (size_t)MPAD * 3328;
constexpr int KVP = 576;
constexpr size_t ZP_U = 512, ZP_GV = 512, ZP_Q = 768, ZP_K = 256, ZP_V = 256, ZP_CX = 512, ZP_CB = 512, ZP_CC = 512;
constexpr float EPS = 1e-6f;
constexpr size_t O_Y = 0, O_KWIN = 16908288, O_VWIN = 19005440, O_KROW = 21102592, O_VROW = 21168128, O_CONVP = 21233664, O_CONVS = 21237760, O_AV = 21303296;
constexpr size_t MiB = 1u << 20;
constexpr size_t WS_W = 1 * MiB, W_LAYER = 36 * MiB;
constexpr size_t WO_IN = 0, WO_BR = 14155776, WO_O = WO_BR + 2621440, WO_GU = WO_O + 2097152, WO_D = WO_GU + 11534336;
static_assert(WO_D + 5767168 <= W_LAYER, "weights");
constexpr size_t WS_R1 = 73 * MiB;
constexpr size_t WS_R2 = 114 * MiB;
constexpr size_t WS_R3 = 147 * MiB;
constexpr size_t WS_Z1 = 180 * MiB;
constexpr size_t WS_G = 302 * MiB;
constexpr size_t WS_END = 400 * MiB;
constexpr size_t R3_LSE = (size_t)3 * MPR * 256 * 2;

constexpr int LDS_BYTES = 147456;

__device__ __forceinline__ unsigned f2bf(float f) { unsigned u = __builtin_bit_cast(unsigned, f); return (u + 0x7fffu + ((u >> 16) & 1u)) >> 16; }
typedef __bf16 bf16x2_t __attribute__((ext_vector_type(2)));
__device__ __forceinline__ unsigned pk2(float lo, float hi) { f32x2 v = {lo, hi}; bf16x2_t b = __builtin_convertvector(v, bf16x2_t); return __builtin_bit_cast(unsigned, b); }
__device__ __forceinline__ float bflo(unsigned w) { return __builtin_bit_cast(float, w << 16); }
__device__ __forceinline__ float bfhi(unsigned w) { return __builtin_bit_cast(float, w & 0xffff0000u); }
__device__ __forceinline__ float bf1(bf16_t b) { return __builtin_bit_cast(float, (unsigned)b << 16); }
__device__ __forceinline__ float sigm(float x) { return __builtin_amdgcn_rcpf(1.f + __expf(-x)); }
__device__ __forceinline__ float gelu_t(float x) { return x * sigm(1.5957691216057308f * x * (1.f + 0.044715f * x * x)); }
__device__ __forceinline__ float wave_sum(float v) {
#pragma unroll
    for (int o = 1; o < 64; o <<= 1) v += __shfl_xor(v, o);
    return v;
}
__device__ __forceinline__ int opaque_bid() { int b = blockIdx.x; asm volatile("" : "+s"(b)); return b; }
__device__ __forceinline__ int opaque_tid() { int t = threadIdx.x; asm volatile("" : "+v"(t)); return t; }
#define LDS_WAIT() asm volatile("s_waitcnt lgkmcnt(0)" ::: "memory")

namespace pg8 {
constexpr int BM = 256, BK = 64, HALF = 128, HTB = HALF * BK * 2, STAGE_BYTES = 8 * HTB, NXCD = 8, WGM = 4;
__host__ __device__ __forceinline__ int lds_byte(int r, int c) { const int st = (r >> 4) * 2 + (c >> 5), rr = r & 15, cc = c & 31, ob = rr * 64 + cc * 2; return st * 1024 + (ob ^ (((ob >> 9) & 1) << 5)); }
__host__ __device__ __forceinline__ void stage_rc(int b, int& R, int& C) { const int st = b / 1024, sb = b % 1024, swz = sb ^ (((sb >> 9) & 1) << 5); R = (st >> 1) * 16 + swz / 64; C = (st & 1) * 32 + (swz % 64) / 2; }
__host__ __device__ __forceinline__ int perm32(int rho) { const int n = rho >> 4, i = rho & 15; return 8 * (i >> 2) + 4 * n + (i & 3); }

struct Unit { int pm, pn; };
struct Gemm { const bf16_t* A; const bf16_t* Bt; };

struct StaticOrder {
    int nM, nN, nwg, G, c;
    __host__ __device__ void init(int M, int N, int G_, int c_) { nM = M / BM; nN = N / BM; nwg = nM * nN; G = G_; c = c_; }
    __host__ __device__ bool next(int i, Unit& u) const {
        const long L = (long)i * G + c; if (L >= nwg) return false;
        int wgid = (int)L; { const int q = nwg / NXCD, r = nwg % NXCD, xcd = wgid % NXCD, off = wgid / NXCD; wgid = (xcd < r ? xcd * (q + 1) : r * (q + 1) + (xcd - r) * q) + off; }
        const int nig = WGM * nN, gid = wgid / nig, fm = gid * WGM, gsz = (nM - fm) < WGM ? (nM - fm) : WGM;
        u.pm = fm + ((wgid % nig) % gsz); u.pn = (wgid % nig) / gsz; return true;
    }
};

template <class Epi, bool ALIGN_EPI, int K_, int LDA_, int LDB_>
__device__ __forceinline__ void gemm_phase(LAS unsigned char* lds, const Gemm g, const StaticOrder& S, const Epi& E) {
    int tid_ = threadIdx.x; asm volatile("" : "+v"(tid_));
    const int tid = tid_, wid = __builtin_amdgcn_readfirstlane(tid >> 6), lane = tid & 63, wr = wid >> 2, wc = wid & 3, fr = lane & 15, fq = lane >> 4;
    constexpr int nt = K_ / BK;
    unsigned voffA[2], voffB[2];
#pragma unroll
    for (int i = 0; i < 2; ++i) { int R, C; stage_rc(tid * 16 + i * 8192, R, C); const int Rb = Epi::PERM ? ((R & ~31) + perm32(R & 31)) : R;
        voffA[i] = (unsigned)(R * LDA_ + C) * 2u; voffB[i] = (unsigned)(Rb * LDB_ + C) * 2u; }
    constexpr size_t kstep = (size_t)(BK * 2);
    constexpr size_t hstepA = (size_t)HALF * LDA_ * 2, hstepB = (size_t)HALF * LDB_ * 2;
    constexpr size_t tstepA = 2 * hstepA, tstepB = 2 * hstepB;
    const unsigned ldsw = (unsigned)wid * 1024u;
    const int aoff = lds_byte(wr * 64 + fr, fq * 8), boff = lds_byte(wc * 32 + fr, fq * 8);
#define PG8_SA(b, h) (((b) * 2 + (h)) * HTB)
#define PG8_SB(b, h) ((4 + (b) * 2 + (h)) * HTB)
#define PG8_STAGE(bufoff, gbase, voff) do { _Pragma("unroll") for (int _i = 0; _i < 2; ++_i) { unsigned _vo = (voff)[_i]; asm volatile("" : "+v"(_vo)); \
        __builtin_amdgcn_global_load_lds((const unsigned*)((const char*)(gbase) + _vo), (LAS unsigned*)(lds + (bufoff) + ldsw + _i * 8192), 16, 0, 0); } } while (0)
#define PG8_LDA(dst, b, h) do { _Pragma("unroll") for (int m = 0; m < 4; ++m) _Pragma("unroll") for (int k = 0; k < 2; ++k) dst[m][k] = *(const LAS bf16x8*)(lds + PG8_SA(b, h) + aoff + m * 2048 + k * 1024); } while (0)
#define PG8_LDB(dst, b, h) do { _Pragma("unroll") for (int n = 0; n < 2; ++n) _Pragma("unroll") for (int k = 0; k < 2; ++k) dst[n][k] = *(const LAS bf16x8*)(lds + PG8_SB(b, h) + boff + n * 2048 + k * 1024); } while (0)
#define PG8_MMA(ai, bj, At, Bt) do { __builtin_amdgcn_s_setprio(1); _Pragma("unroll") for (int m = 0; m < 4; ++m) _Pragma("unroll") for (int n = 0; n < 2; ++n) _Pragma("unroll") for (int k = 0; k < 2; ++k) \
        acc[ai][bj][m][n] = __builtin_amdgcn_mfma_f32_16x16x32_bf16(Bt[n][k], At[m][k], acc[ai][bj][m][n], 0, 0, 0); __builtin_amdgcn_s_setprio(0); } while (0)
#define PG8_WAIT_V(n) asm volatile("s_waitcnt vmcnt(" #n ")" ::: "memory")
#define PG8_WAIT_L(n) asm volatile("s_waitcnt lgkmcnt(" #n ")" ::: "memory")
#define PG8_BAR __builtin_amdgcn_s_barrier()
#define PG8_SCHED __builtin_amdgcn_sched_barrier(0)
    Unit cur, nxt; int ui = 0;
    if (!S.next(0, cur)) return;
    f32x4 acc[2][2][4][2];
#pragma unroll
    for (int a = 0; a < 2; ++a)
#pragma unroll
        for (int b = 0; b < 2; ++b)
#pragma unroll
            for (int m = 0; m < 4; ++m)
#pragma unroll
                for (int n = 0; n < 2; ++n) acc[a][b][m][n] = (f32x4){0.f, 0.f, 0.f, 0.f};
    bf16x8 At[4][2], B0[2][2], B1[2][2];
    const char* cA = (const char*)g.A + (size_t)cur.pm * tstepA; const char* cB = (const char*)g.Bt + (size_t)cur.pn * tstepB;
    PG8_SCHED; PG8_STAGE(PG8_SB(0, 0), cB, voffB); PG8_SCHED; PG8_STAGE(PG8_SB(0, 1), cB + hstepB, voffB); PG8_SCHED; PG8_STAGE(PG8_SA(0, 0), cA, voffA); PG8_SCHED; PG8_STAGE(PG8_SA(0, 1), cA + hstepA, voffA); PG8_SCHED;
    if (wr == 1) PG8_BAR;
    PG8_WAIT_V(2); PG8_BAR; PG8_SCHED;
    PG8_STAGE(PG8_SB(1, 0), cB + kstep, voffB); PG8_SCHED; PG8_STAGE(PG8_SA(1, 0), cA + kstep, voffA); PG8_SCHED; PG8_STAGE(PG8_SB(1, 1), cB + hstepB + kstep, voffB); PG8_SCHED;
    PG8_WAIT_V(6); PG8_BAR; PG8_SCHED;
    for (;;) {
        const bool has_next = S.next(ui + 1, nxt);
        const char* nA = has_next ? (const char*)g.A + (size_t)nxt.pm * tstepA : cA; const char* nB = has_next ? (const char*)g.Bt + (size_t)nxt.pn * tstepB : cB;
#define PG8_KLOOP(T0, T1) for (int t = (T0); t < (T1); t += 2) { \
            const bool last = (t == nt - 2); \
            const char* a1 = cA + (size_t)(t + 1) * kstep; \
            const char* a2 = last ? nA : cA + (size_t)(t + 2) * kstep; const char* b2 = last ? nB : cB + (size_t)(t + 2) * kstep; \
            const char* a3 = a2 + kstep; const char* b3 = b2 + kstep; \
            PG8_LDB(B0, 0, 0); PG8_LDB(B1, 0, 1); PG8_SCHED; PG8_LDA(At, 0, 0); PG8_STAGE(PG8_SA(1, 1), a1 + hstepA, voffA); \
            PG8_WAIT_V(8); PG8_WAIT_L(0); PG8_BAR; PG8_MMA(0, 0, At, B0); PG8_MMA(0, 1, At, B1); PG8_BAR; PG8_SCHED; \
            PG8_LDA(At, 0, 1); PG8_STAGE(PG8_SB(0, 0), b2, voffB); PG8_STAGE(PG8_SB(0, 1), b2 + hstepB, voffB); PG8_STAGE(PG8_SA(0, 0), a2, voffA); \
            PG8_WAIT_V(8); PG8_WAIT_L(0); PG8_BAR; PG8_MMA(1, 0, At, B0); PG8_MMA(1, 1, At, B1); PG8_BAR; PG8_SCHED; \
            PG8_LDB(B0, 1, 0); PG8_LDB(B1, 1, 1); PG8_SCHED; PG8_LDA(At, 1, 0); PG8_STAGE(PG8_SA(0, 1), a2 + hstepA, voffA); \
            PG8_WAIT_V(8); PG8_WAIT_L(0); PG8_BAR; PG8_MMA(0, 0, At, B0); PG8_MMA(0, 1, At, B1); PG8_BAR; PG8_SCHED; \
            PG8_LDA(At, 1, 1); PG8_STAGE(PG8_SB(1, 0), b3, voffB); PG8_STAGE(PG8_SB(1, 1), b3 + hstepB, voffB); PG8_STAGE(PG8_SA(1, 0), a3, voffA); \
            PG8_WAIT_V(8); PG8_WAIT_L(0); PG8_BAR; PG8_MMA(1, 0, At, B0); PG8_MMA(1, 1, At, B1); PG8_BAR; PG8_SCHED; \
        }
        if constexpr (Epi::FLUSH) { PG8_KLOOP(0, Epi::F1) E.flush(acc, cur, 0, wr, wc, fr, fq); PG8_SCHED; PG8_KLOOP(Epi::F1, Epi::F2) E.flush(acc, cur, 1, wr, wc, fr, fq); PG8_SCHED; PG8_KLOOP(Epi::F2, nt) }
        else { PG8_KLOOP(0, nt) }
#undef PG8_KLOOP
        if constexpr (ALIGN_EPI) { if (wr == 0) PG8_BAR; }
        E(acc, cur, wr, wc, fr, fq);
        if (!has_next) break;
#pragma unroll
        for (int a = 0; a < 2; ++a)
#pragma unroll
            for (int b = 0; b < 2; ++b)
#pragma unroll
                for (int m = 0; m < 4; ++m)
#pragma unroll
                    for (int n = 0; n < 2; ++n) acc[a][b][m][n] = (f32x4){0.f, 0.f, 0.f, 0.f};
        cur = nxt; cA = nA; cB = nB; ++ui;
        if constexpr (ALIGN_EPI) { if (wr == 1) PG8_BAR; }
    }
    PG8_WAIT_V(0);
    if constexpr (!ALIGN_EPI) { if (wr == 0) PG8_BAR; }
    PG8_BAR;
#undef PG8_SA
#undef PG8_SB
#undef PG8_STAGE
#undef PG8_LDA
#undef PG8_LDB
#undef PG8_MMA
#undef PG8_WAIT_V
#undef PG8_WAIT_L
#undef PG8_BAR
#undef PG8_SCHED
}

__device__ __forceinline__ u32x4 pack8(const f32x4 v0, const f32x4 v1) { u32x4 w; w.x = pk2(v0[0], v0[1]); w.y = pk2(v0[2], v0[3]); w.z = pk2(v1[0], v1[1]); w.w = pk2(v1[2], v1[3]); return w; }

struct EpiBf16 {
    static constexpr bool PERM = true, FLUSH = false;
    bf16_t* O; int ldc;
    __device__ __forceinline__ void operator()(const f32x4 (&acc)[2][2][4][2], const Unit& u, int wr, int wc, int fr, int fq) const {
        const int row0 = u.pm * BM + wr * 64 + fr, col0 = u.pn * BM + wc * 32 + 8 * fq;
#pragma unroll
        for (int ai = 0; ai < 2; ++ai)
#pragma unroll
            for (int m = 0; m < 4; ++m) { bf16_t* rowp = O + (size_t)(row0 + ai * HALF + m * 16) * ldc + col0;
#pragma unroll
                for (int bj = 0; bj < 2; ++bj) *(u32x4*)(rowp + bj * HALF) = pack8(acc[ai][bj][m][0], acc[ai][bj][m][1]); }
    }
};

struct EpiSwiglu {
    static constexpr bool PERM = true, FLUSH = false;
    bf16_t* O;
    __device__ __forceinline__ void operator()(const f32x4 (&acc)[2][2][4][2], const Unit& u, int wr, int wc, int fr, int fq) const {
        const int row0 = u.pm * BM + wr * 64 + fr, col0 = u.pn * HALF + wc * 32 + 8 * fq;
#pragma unroll
        for (int ai = 0; ai < 2; ++ai)
#pragma unroll
            for (int m = 0; m < 4; ++m) { bf16_t* rowp = O + (size_t)(row0 + ai * HALF + m * 16) * FF + col0;
                f32x4 v0, v1;
#pragma unroll
                for (int i = 0; i < 4; ++i) { const float g0 = acc[ai][0][m][0][i], g1 = acc[ai][0][m][1][i];
                    v0[i] = g0 * sigm(g0) * acc[ai][1][m][0][i]; v1[i] = g1 * sigm(g1) * acc[ai][1][m][1][i]; }
                *(u32x4*)rowp = pack8(v0, v1); }
    }
};

struct EpiGated {
    static constexpr bool PERM = true, FLUSH = true;
    static constexpr int F1 = 8, F2 = 12;
    const bf16_t* G; bf16_t* O;
    __device__ __forceinline__ void flush(f32x4 (&acc)[2][2][4][2], const Unit& u, int which, int wr, int wc, int fr, int fq) const {
        int row0 = u.pm * BM + wr * 64 + fr; asm volatile("" : "+v"(row0));
        const int col0 = u.pn * BM + wc * 32 + 8 * fq;
        const bf16_t* gbase = G + (size_t)row0 * GW + which * DM + col0; asm volatile("" : "+v"(gbase));
        u32x4 gn[2][2], gd[2][2];
#pragma unroll
        for (int bj = 0; bj < 2; ++bj) { const bf16_t* gp = gbase + bj * HALF; gn[0][bj] = *(const u32x4*)gp; gd[0][bj] = *(const u32x4*)(gp + DM); }
#pragma unroll
        for (int st = 0; st < 8; ++st) {
            const int ai = st >> 2, m = st & 3, cur = st & 1, nx = cur ^ 1;
            if (st < 7) { const int ai2 = (st + 1) >> 2, m2 = (st + 1) & 3;
#pragma unroll
                for (int bj = 0; bj < 2; ++bj) { const bf16_t* gp = gbase + (size_t)(ai2 * HALF + m2 * 16) * GW + bj * HALF; gn[nx][bj] = *(const u32x4*)gp; gd[nx][bj] = *(const u32x4*)(gp + DM); } }
#pragma unroll
            for (int bj = 0; bj < 2; ++bj) { const u32x4 a = gn[cur][bj], d = gd[cur][bj];
                float num[8] = {bflo(a.x), bfhi(a.x), bflo(a.y), bfhi(a.y), bflo(a.z), bfhi(a.z), bflo(a.w), bfhi(a.w)};
                float den[8] = {bflo(d.x), bfhi(d.x), bflo(d.y), bfhi(d.y), bflo(d.z), bfhi(d.z), bflo(d.w), bfhi(d.w)};
#pragma unroll
                for (int i = 0; i < 4; ++i) { const float n0 = which ? fmaxf(num[i], 1e-30f) : num[i], n1 = which ? fmaxf(num[4 + i], 1e-30f) : num[4 + i];
                    acc[ai][bj][m][0][i] *= n0 * __builtin_amdgcn_rcpf(fmaxf(den[i], 1e-30f)); acc[ai][bj][m][1][i] *= n1 * __builtin_amdgcn_rcpf(fmaxf(den[4 + i], 1e-30f)); } }
            __builtin_amdgcn_sched_barrier(0);
        }
    }
    __device__ __forceinline__ void operator()(const f32x4 (&acc)[2][2][4][2], const Unit& u, int wr, int wc, int fr, int fq) const {
        const int row0 = u.pm * BM + wr * 64 + fr, col0 = u.pn * BM + wc * 32 + 8 * fq;
#pragma unroll
        for (int ai = 0; ai < 2; ++ai)
#pragma unroll
            for (int m = 0; m < 4; ++m) { const size_t row = (size_t)(row0 + ai * HALF + m * 16);
#pragma unroll
                for (int bj = 0; bj < 2; ++bj) { const int col = col0 + bj * HALF;
                    const u32x4 gw = *(const u32x4*)(G + row * GW + 2 * DM + col);
                    f32x4 v0 = acc[ai][bj][m][0], v1 = acc[ai][bj][m][1];
                    v0[0] *= fmaxf(bflo(gw.x), 1e-30f); v0[1] *= fmaxf(bfhi(gw.x), 1e-30f); v0[2] *= fmaxf(bflo(gw.y), 1e-30f); v0[3] *= fmaxf(bfhi(gw.y), 1e-30f);
                    v1[0] *= fmaxf(bflo(gw.z), 1e-30f); v1[1] *= fmaxf(bfhi(gw.z), 1e-30f); v1[2] *= fmaxf(bflo(gw.w), 1e-30f); v1[3] *= fmaxf(bfhi(gw.w), 1e-30f);
                    *(u32x4*)(O + row * DM + col) = pack8(v0, v1); } }
    }
};

struct EpiIn {
    static constexpr bool PERM = true, FLUSH = false;
    bf16_t* Z1; bf16_t* G; const float* bgate; float* okwin; float* ovwin; float* okrow; float* ovrow; float* stats;
    __device__ __forceinline__ void operator()(const f32x4 (&acc)[2][2][4][2], const Unit& u, int wr, int wc, int fr, int fq) const {
        const int pn = u.pn, row0 = u.pm * BM + wr * 64 + fr, ct = wc * 32 + 8 * fq;
        if (pn < 15) {
            const bool gel = pn < 4; const bool kv = (pn == 7) || (pn == 8); const bool st = (pn == 2) || (pn == 3);
            long zb; int zp, zc; const long kvoff = ((long)WS_R2 - (long)WS_Z1) / 2;
            if (pn < 2) { zb = (long)ZB_U; zp = 512; zc = pn * 256; } else if (pn < 4) { zb = (long)ZB_GV; zp = 512; zc = (pn - 2) * 256; } else if (pn < 7) { zb = (long)ZB_Q; zp = 768; zc = (pn - 4) * 256; }
            else if (pn == 7) { zb = kvoff; zp = KVP; zc = 0; } else if (pn == 8) { zb = kvoff; zp = KVP; zc = 256; } else if (pn < 11) { zb = (long)ZB_CX; zp = 512; zc = (pn - 9) * 256; }
            else if (pn < 13) { zb = (long)ZB_CB; zp = 512; zc = (pn - 11) * 256; } else { zb = (long)ZB_CC; zp = 512; zc = (pn - 13) * 256; }
#pragma unroll
            for (int ai = 0; ai < 2; ++ai)
#pragma unroll
                for (int m = 0; m < 4; ++m) { const int row = row0 + ai * HALF + m * 16; bf16_t* rowp = Z1 + (zb + (long)row * zp + zc + ct);
                    float* dst = nullptr;
                    if (kv) { if (row < MPR) { const int s = row & (SEQ - 1); if (s >= SEQ - 2048) dst = (pn == 7 ? okwin : ovwin) + (size_t)((row >> 13) * 2048 + (s - (SEQ - 2048))) * 256; }
                              else if (row < MR) dst = (pn == 7 ? okrow : ovrow) + (size_t)(row - MPR) * 256; }
                    float ssum = 0.f, qsum = 0.f;
#pragma unroll
                    for (int bj = 0; bj < 2; ++bj) { f32x4 v0 = acc[ai][bj][m][0], v1 = acc[ai][bj][m][1];
                        if (gel) {
#pragma unroll
                            for (int i = 0; i < 4; ++i) { v0[i] = gelu_t(v0[i]); v1[i] = gelu_t(v1[i]); } }
                        if (st) {
#pragma unroll
                            for (int i = 0; i < 4; ++i) { ssum += v0[i] + v1[i]; qsum += v0[i] * v0[i] + v1[i] * v1[i]; } }
                        *(u32x4*)(rowp + bj * HALF) = pack8(v0, v1);
                        if (dst) { *(f32x4*)(dst + bj * HALF + ct) = v0; *(f32x4*)(dst + bj * HALF + ct + 4) = v1; } }
                    if (st) { ssum += __shfl_xor(ssum, 16); ssum += __shfl_xor(ssum, 32); qsum += __shfl_xor(qsum, 16); qsum += __shfl_xor(qsum, 32);
                        if (fq == 0 && row < MR) { atomicAdd(stats + (size_t)row * 2, ssum); atomicAdd(stats + (size_t)row * 2 + 1, qsum); } } }
        } else {
            const int cb = (pn - 15) * BM + ct;
#pragma unroll
            for (int bj = 0; bj < 2; ++bj) { const f32x4 b0 = *(const f32x4*)(bgate + cb + bj * HALF), b1 = *(const f32x4*)(bgate + cb + bj * HALF + 4);
#pragma unroll
                for (int ai = 0; ai < 2; ++ai)
#pragma unroll
                    for (int m = 0; m < 4; ++m) { const int row = row0 + ai * HALF + m * 16; f32x4 v0 = acc[ai][bj][m][0] + b0, v1 = acc[ai][bj][m][1] + b1;
#pragma unroll
                        for (int i = 0; i < 4; ++i) { v0[i] = sigm(v0[i]); v1[i] = sigm(v1[i]); }
                        *(u32x4*)(G + (size_t)row * GW + cb + bj * HALF) = pack8(v0, v1); } }
        }
    }
};
}

struct Params { const float* in[24]; float* out; unsigned char* ws; int ph_lo, ph_hi; };

__device__ __forceinline__ void transpose_item(const float* W, int N, int k0, int n0, bf16_t* WT, int ldt, int dst_row0, int dst_col0, LAS float* scr, int lane) {
#pragma unroll 8
    for (int i = 0; i < 32; ++i) { const int kk = 2 * i + (lane >> 5); scr[kk * 33 + (lane & 31)] = W[(size_t)(k0 + kk) * N + n0 + (lane & 31)]; }
    LDS_WAIT(); asm volatile("" ::: "memory");
    const int c = lane & 7;
#pragma unroll
    for (int j = 0; j < 4; ++j) { const int n = (lane >> 3) + 8 * j; const LAS float* s = scr + (8 * c) * 33 + n;
        u32x4 o; o.x = pk2(s[0 * 33], s[1 * 33]); o.y = pk2(s[2 * 33], s[3 * 33]); o.z = pk2(s[4 * 33], s[5 * 33]); o.w = pk2(s[6 * 33], s[7 * 33]);
        *(u32x4*)(WT + (size_t)(dst_row0 + n) * ldt + dst_col0 + k0 + 8 * c) = o; }
    LDS_WAIT(); asm volatile("" ::: "memory");
}

__device__ __forceinline__ void rms_row_to_bf16(const float* xrow, const float* gain, bf16_t* orow, int lane) {
    f32x4 v[4]; float s = 0.f;
#pragma unroll
    for (int j = 0; j < 4; ++j) { v[j] = *(const f32x4*)(xrow + 4 * lane + 256 * j); s += (v[j].x * v[j].x + v[j].y * v[j].y) + (v[j].z * v[j].z + v[j].w * v[j].w); }
    const float r = 1.f / sqrtf(wave_sum(s) * (1.f / DM) + EPS);
#pragma unroll
    for (int j = 0; j < 4; ++j) { const f32x4 gg = *(const f32x4*)(gain + 4 * lane + 256 * j);
        u32x2 o; o.x = pk2(v[j].x * r * gg.x, v[j].y * r * gg.y); o.y = pk2(v[j].z * r * gg.z, v[j].w * r * gg.w);
        *(u32x2*)(orow + 4 * lane + 256 * j) = o; }
}

constexpr int CV_I_IN = 16 * 216, CV_I_BA = 8 * 32, CV_I_BB = 4 * 32, CV_I_BC = 8 * 32, CV_I_O = 16 * 32, CV_I_G = 16 * 88, CV_I_U = 16 * 88, CV_I_D = 44 * 32;
constexpr int CV_SPLIT = 2304;
constexpr int CV_PER_LAYER = CV_I_IN + CV_I_BA + CV_I_BB + CV_I_BC + CV_I_O + CV_I_G + CV_I_U + CV_I_D;
__device__ __forceinline__ void convert_items(const Params& P, LAS unsigned char* lds, int l, int it0, int stride, int it_end = CV_PER_LAYER) {
    const int tid = opaque_tid(), lane = tid & 63, wave = tid >> 6;
    LAS float* scr = (LAS float*)(lds + wave * 16384);
    unsigned char* wl = P.ws + WS_W + (size_t)l * W_LAYER;
    for (int it = it0; it < it_end; it += stride) {
        int r = it;
        if (r < CV_I_IN) { const int kb = r / 216, nb = r % 216; transpose_item(P.in[9] + (size_t)l * DM * INW, INW, 64 * kb, 32 * nb, (bf16_t*)(wl + WO_IN), DM, 32 * nb, 0, scr, lane); continue; } r -= CV_I_IN;
        if (r < CV_I_BA) { const int kb = r / 32, nb = r % 32; transpose_item(P.in[16] + (size_t)l * 512 * DM, DM, 64 * kb, 32 * nb, (bf16_t*)(wl + WO_BR), MIXW, 32 * nb, 0, scr, lane); continue; } r -= CV_I_BA;
        if (r < CV_I_BB) { const int kb = r / 32, nb = r % 32; transpose_item(P.in[17] + (size_t)l * 256 * DM, DM, 64 * kb, 32 * nb, (bf16_t*)(wl + WO_BR), MIXW, 32 * nb, 512, scr, lane); continue; } r -= CV_I_BB;
        if (r < CV_I_BC) { const int kb = r / 32, nb = r % 32; transpose_item(P.in[18] + (size_t)l * 512 * DM, DM, 64 * kb, 32 * nb, (bf16_t*)(wl + WO_BR), MIXW, 32 * nb, 768, scr, lane); continue; } r -= CV_I_BC;
        if (r < CV_I_O) { const int kb = r / 32, nb = r % 32; transpose_item(P.in[20] + (size_t)l * DM * DM, DM, 64 * kb, 32 * nb, (bf16_t*)(wl + WO_O), DM, 32 * nb, 0, scr, lane); continue; } r -= CV_I_O;
        if (r < CV_I_G) { const int kb = r / 88, nb = r % 88; const int n0 = 32 * nb; transpose_item(P.in[21] + (size_t)l * DM * FF, FF, 64 * kb, n0, (bf16_t*)(wl + WO_GU), DM, (n0 >> 7) * 256 + (n0 & 127), 0, scr, lane); continue; } r -= CV_I_G;
        if (r < CV_I_U) { const int kb = r / 88, nb = r % 88; const int n0 = 32 * nb; transpose_item(P.in[22] + (size_t)l * DM * FF, FF, 64 * kb, n0, (bf16_t*)(wl + WO_GU), DM, (n0 >> 7) * 256 + (n0 & 127) + 128, 0, scr, lane); continue; } r -= CV_I_U;
        { const int kb = r / 32, nb = r % 32; transpose_item(P.in[23] + (size_t)l * FF * DM, DM, 64 * kb, 32 * nb, (bf16_t*)(wl + WO_D), FF, 32 * nb, 0, scr, lane); }
    }
}
__device__ __forceinline__ int up_full_blocks(int G) { const int nwg = (MPAD / 256) * (2 * FF / 256); const int rounds = (nwg + G - 1) / G; return nwg - (rounds - 1) * G; }
__device__ __forceinline__ bool defer_layer1(int G) { const int nf = up_full_blocks(G); return (G - nf) >= 64; }
__device__ __forceinline__ void phase_prologue(const Params& P, LAS unsigned char* lds) {
    const int tid = opaque_tid(), lane = tid & 63, wave = tid >> 6;
    const int gw = opaque_bid() * 8 + wave, NGW = gridDim.x * 8;
    convert_items(P, lds, 0, gw, NGW);
    if (!defer_layer1(gridDim.x)) convert_items(P, lds, 1, gw, NGW);
    bf16_t* H = (bf16_t*)(P.ws + WS_R1);
    for (int m = gw; m < MR; m += NGW) {
        const float* xr = m < MPR ? P.in[0] + (size_t)m * DM : P.in[1] + (size_t)(m - MPR) * DM;
        rms_row_to_bf16(xr, P.in[5], H + (size_t)m * DM, lane);
    }
}

__device__ __forceinline__ float alibi_slope(int i) { return exp2f(-8.0f * (float)(i + 1) / 12.0f); }

constexpr int KS_PITCH = 72, VT_PITCH = 264;
constexpr int ATT_VT = 256 * KS_PITCH * 2, ATT_BUF = ATT_VT + 64 * VT_PITCH * 2;
struct AttnPre { u32x4 kk[4], vv[4]; bf16x8 qf[2]; };
__device__ __forceinline__ void attn_decode(int u, int& b, int& g, int& tile, int& h) { const int bb = u & 255, xq = bb & 7, j = bb >> 3; h = j & 3; tile = 8 * xq + (j >> 2); const int bg = u >> 8; b = bg / 3; g = bg - 3 * b; }
__device__ __forceinline__ void attn_prefetch(const Params& P, int u, int tid, AttnPre& R) {
    int b, g, tile, h; attn_decode(u, b, g, tile, h);
    const int lane = tid & 63, w = tid >> 6, fr = lane & 15, fq = lane >> 4;
    const int sh = 2 * g, dil = 1 << sh, r = tile & (dil - 1), n = tile >> sh;
    const bf16_t* Z1 = (const bf16_t*)(P.ws + WS_Z1);
#pragma unroll
    for (int i = 0; i < 4; ++i) {
        const int c = tid + 512 * i, key = c >> 3, part = c & 7;
        const int jp = 128 * (n - 1) + key;
        R.kk[i] = (u32x4){0u, 0u, 0u, 0u}; R.vv[i] = (u32x4){0u, 0u, 0u, 0u};
        if (jp >= 0) { const bf16_t* rp = (const bf16_t*)(P.ws + WS_R2) + (size_t)(b * SEQ + jp * dil + r) * KVP + h * 64 + 8 * part;
            R.kk[i] = *(const u32x4*)rp; R.vv[i] = *(const u32x4*)(rp + 256); }
    }
    const int q = 16 * w + fr;
    const size_t qrow = (size_t)(b * SEQ + (128 * n + q) * dil + r);
    const bf16_t* qp = Z1 + ZB_Q + qrow * ZP_Q + (g * 4 + h) * 64 + 8 * fq; R.qf[0] = *(const bf16x8*)qp; R.qf[1] = *(const bf16x8*)(qp + 32);
}
__device__ __forceinline__ void attn_stage(LAS unsigned char* buf, int tid, const AttnPre& R) {
    LAS bf16_t* Ks = (LAS bf16_t*)buf; LAS bf16_t* Vt = (LAS bf16_t*)(buf + ATT_VT);
#pragma unroll
    for (int i = 0; i < 4; ++i) {
        const int c = tid + 512 * i, key = c >> 3, part = c & 7;
        *(LAS u32x4*)(Ks + key * KS_PITCH + 8 * part) = R.kk[i];
        LAS bf16_t* vp = Vt + (8 * part) * VT_PITCH + (key ^ (part << 3));
        const u32x4 vv = R.vv[i];
        vp[0 * VT_PITCH] = (bf16_t)(vv.x & 0xffffu); vp[1 * VT_PITCH] = (bf16_t)(vv.x >> 16);
        vp[2 * VT_PITCH] = (bf16_t)(vv.y & 0xffffu); vp[3 * VT_PITCH] = (bf16_t)(vv.y >> 16);
        vp[4 * VT_PITCH] = (bf16_t)(vv.z & 0xffffu); vp[5 * VT_PITCH] = (bf16_t)(vv.z >> 16);
        vp[6 * VT_PITCH] = (bf16_t)(vv.w & 0xffffu); vp[7 * VT_PITCH] = (bf16_t)(vv.w >> 16);
    }
}
__device__ __forceinline__ void attn_compute(const Params& P, LAS unsigned char* buf, int u, int tid, const bf16x8 (&qf)[2]) {
    int b, g, tile, h; attn_decode(u, b, g, tile, h);
    const int lane = tid & 63, w = tid >> 6, fr = lane & 15, fq = lane >> 4;
    const int sh = 2 * g, dil = 1 << sh, r = tile & (dil - 1), n = tile >> sh;
    const LAS bf16_t* Ks = (const LAS bf16_t*)buf; const LAS bf16_t* Vt = (const LAS bf16_t*)(buf + ATT_VT);
    const int q = 16 * w + fr;
    const size_t qrow = (size_t)(b * SEQ + (128 * n + q) * dil + r);
    const float sl = alibi_slope(g * 4 + h) * (float)dil;
    f32x4 sc[9];
    float mx = -INFINITY;
#pragma unroll
    for (int kb = 0; kb < 9; ++kb) {
        const LAS bf16_t* kp = Ks + (16 * (w + kb) + fr) * KS_PITCH + 8 * fq;
        f32x4 a = (f32x4){0.f, 0.f, 0.f, 0.f};
        a = __builtin_amdgcn_mfma_f32_16x16x32_bf16(*(const LAS bf16x8*)kp, qf[0], a, 0, 0, 0);
        a = __builtin_amdgcn_mfma_f32_16x16x32_bf16(*(const LAS bf16x8*)(kp + 32), qf[1], a, 0, 0, 0);
#pragma unroll
        for (int i = 0; i < 4; ++i) {
            const int dist = fr + 128 - 16 * kb - 4 * fq - i;
            const int kidx = 16 * (w + kb) + 4 * fq + i;
            const bool valid = (dist >= 0) && (dist <= 128) && (n > 0 || kidx >= 128);
            const float sv = valid ? a[i] * 0.125f - sl * (float)dist : -INFINITY;
            a[i] = sv; mx = fmaxf(mx, sv);
        }
        sc[kb] = a;
    }
    mx = fmaxf(mx, __shfl_xor(mx, 16)); mx = fmaxf(mx, __shfl_xor(mx, 32));
    float den = 0.f;
    f32x4 o[4];
#pragma unroll
    for (int d = 0; d < 4; ++d) o[d] = (f32x4){0.f, 0.f, 0.f, 0.f};
#pragma unroll
    for (int kb = 0; kb < 9; ++kb) {
        f32x4 p;
#pragma unroll
        for (int i = 0; i < 4; ++i) { p[i] = __expf(sc[kb][i] - mx); den += p[i]; }
        u32x2 pw; pw.x = pk2(p[0], p[1]); pw.y = pk2(p[2], p[3]);
        const bf16x4 pf = __builtin_bit_cast(bf16x4, pw);
#pragma unroll
        for (int d = 0; d < 4; ++d) {
            const int vrow = 16 * d + fr;
            const bf16x4 vf = *(const LAS bf16x4*)(Vt + vrow * VT_PITCH + ((16 * (w + kb) + 4 * fq) ^ (((vrow >> 3) & 7) << 3)));
            o[d] = __builtin_amdgcn_mfma_f32_16x16x16bf16_1k(vf, pf, o[d], 0, 0, 0);
        }
    }
    den += __shfl_xor(den, 16); den += __shfl_xor(den, 32);
    const float rden = 1.f / den;
    bf16_t* og = (bf16_t*)(P.ws + WS_R3) + ((size_t)g * MPR + qrow) * 256 + h * 64 + 4 * fq;
#pragma unroll
    for (int d = 0; d < 4; ++d) { u32x2 ow; ow.x = pk2(o[d][0] * rden, o[d][1] * rden); ow.y = pk2(o[d][2] * rden, o[d][3] * rden); *(u32x2*)(og + 16 * d) = ow; }
    if (fq == 0) { float* lse = (float*)(P.ws + WS_R3 + R3_LSE); lse[((size_t)g * MPR + qrow) * 4 + h] = mx + __logf(den); }
}
__device__ __forceinline__ void attn_prompt_loop(const Params& P, LAS unsigned char* lds) {
    const int tid = opaque_tid(); const int G = gridDim.x;
    int u = opaque_bid();
    if (u >= 1536) return;
    AttnPre R; attn_prefetch(P, u, tid, R);
    int buf = 0;
    for (;;) {
        bf16x8 qc[2] = {R.qf[0], R.qf[1]};
        attn_stage(lds + buf * ATT_BUF, tid, R);
        const int un = u + G;
        if (un < 1536) attn_prefetch(P, un, tid, R);
        __syncthreads();
        attn_compute(P, lds + buf * ATT_BUF, u, tid, qc);
        if (un >= 1536) break;
        u = un; buf ^= 1;
    }
    __syncthreads();
}

constexpr int SPN = 24;
constexpr size_t R3_SPO = 25 * MiB, R3_SPML = R3_SPO + (size_t)128 * SPN * 256 * 4;
__device__ __forceinline__ void attn_sample_wave(const Params& P, int l, int wu) {
    const int lane = opaque_tid() & 63, h = lane >> 4, dq = (lane & 15) * 4;
    const int qt = wu & 7, g = (wu >> 3) % 3, rt = wu / 24, db = rt >> 2, t = rt & 3;
    const bf16_t* Z1 = (const bf16_t*)(P.ws + WS_Z1);
    const size_t row = (size_t)(MPR + rt);
    const float* ck = P.in[2] + ((size_t)(l * 32 + db) * 2048) * 256 + h * 64 + dq;
    const float* cv = P.in[3] + ((size_t)(l * 32 + db) * 2048) * 256 + h * 64 + dq;
    const float* nk = P.out + O_KROW + ((size_t)(l * 128 + db * 4)) * 256 + h * 64 + dq;
    const float* nv = P.out + O_VROW + ((size_t)(l * 128 + db * 4)) * 256 + h * 64 + dq;
    const int dil = 1 << (2 * g);
    const float sl = alibi_slope(g * 4 + h) * (float)dil;
    f32x4 q4;
    { const u32x2 qw = *(const u32x2*)(Z1 + ZB_Q + row * ZP_Q + (g * 4 + h) * 64 + dq); q4 = (f32x4){bflo(qw.x), bfhi(qw.x), bflo(qw.y), bfhi(qw.y)} * 0.125f; }
    const int j0 = 17 * qt;
    f32x4 kr[17], vr[17];
#pragma unroll
    for (int i = 0; i < 17; ++i) { const int j = j0 + i; const int jj = j < 129 ? j : 128; const int idx = 2048 + t - dil * jj;
        kr[i] = *(const f32x4*)(idx < 2048 ? ck + (size_t)idx * 256 : nk + (size_t)(idx - 2048) * 256);
        vr[i] = *(const f32x4*)(idx < 2048 ? cv + (size_t)idx * 256 : nv + (size_t)(idx - 2048) * 256); }
    float sv[17]; float m = -INFINITY;
#pragma unroll
    for (int i = 0; i < 17; ++i) { const int j = j0 + i;
        float d = (q4.x * kr[i].x + q4.y * kr[i].y) + (q4.z * kr[i].z + q4.w * kr[i].w);
        d += __shfl_xor(d, 1); d += __shfl_xor(d, 2); d += __shfl_xor(d, 4); d += __shfl_xor(d, 8);
        sv[i] = j < 129 ? d - sl * (float)j : -INFINITY; m = fmaxf(m, sv[i]); }
    f32x4 o4 = (f32x4){0.f, 0.f, 0.f, 0.f}; float lsum = 0.f;
#pragma unroll
    for (int i = 0; i < 17; ++i) { const float p = __expf(sv[i] - m); lsum += p; o4 += vr[i] * p; }
    float* spo = (float*)(P.ws + WS_R3 + R3_SPO) + ((size_t)rt * SPN + g * 8 + qt) * 256 + h * 64 + dq;
    *(f32x4*)spo = o4;
    if ((lane & 15) == 0) { float* ml = (float*)(P.ws + WS_R3 + R3_SPML) + (((size_t)rt * SPN + g * 8 + qt) * 4 + h) * 2; ml[0] = m; ml[1] = lsum; }
}

constexpr int GP = 136;
constexpr int GPX = 184;
constexpr int GATE_WT = 0, GATE_RS = 128 * GP * 2, GATE_XT = GATE_RS + 512, GATE_XT_BYTES = 128 * GPX * 2;
struct GatePre { u32x4 xv[4]; f32x2 sq[4]; u32x2 uw[8]; };
__device__ __forceinline__ void gate_prefetch(const Params& P, int l, int u, int tid, GatePre& R) {
    const int chunk = u >> 2, g = u & 3; const int lane = tid & 63, w = tid >> 6, fr = lane & 15, fq = lane >> 4;
    const bf16_t* Z1 = (const bf16_t*)(P.ws + WS_Z1);
    const float* stats = (const float*)(P.ws + 65536) + (size_t)l * MR * 2;
    const size_t row0 = (size_t)chunk * 128;
#pragma unroll
    for (int i = 0; i < 4; ++i) { const int item = tid + 512 * i, ss = item >> 4, oc = item & 15;
        R.xv[i] = *(const u32x4*)(Z1 + ZB_GV + (row0 + ss) * ZP_GV + g * 128 + 8 * oc); R.sq[i] = *(const f32x2*)(stats + (row0 + ss) * 2); }
    const bf16_t* up = Z1 + ZB_U + (row0 + 16 * w + fr) * ZP_U + g * 128 + 4 * fq;
#pragma unroll
    for (int cb = 0; cb < 8; ++cb) R.uw[cb] = *(const u32x2*)(up + 16 * cb);
}
__device__ __forceinline__ void gate_stage_w(const Params& P, LAS unsigned char* lds, int l, int g, int tid) {
    LAS bf16_t* Wt = (LAS bf16_t*)(lds + GATE_WT); LAS float* rs = (LAS float*)(lds + GATE_RS);
    const float* Wsrc = P.in[12] + (size_t)(l * 4 + g) * 128 * 128;
    f32x4 wv[8];
#pragma unroll
    for (int i = 0; i < 8; ++i) wv[i] = *(const f32x4*)(Wsrc + (tid + 512 * i) * 4);
#pragma unroll
    for (int i = 0; i < 8; ++i) {
        const int e = (tid + 512 * i) * 4, tt = e >> 7, ss = e & 127;
        f32x4 x = wv[i]; x.x = ss <= tt ? x.x : 0.f; x.y = ss + 1 <= tt ? x.y : 0.f; x.z = ss + 2 <= tt ? x.z : 0.f; x.w = ss + 3 <= tt ? x.w : 0.f;
        u32x2 o; o.x = pk2(x.x, x.y); o.y = pk2(x.z, x.w);
        *(LAS u32x2*)(Wt + tt * GP + ss) = o;
        float ps = (x.x + x.y) + (x.z + x.w);
        ps += __shfl_xor(ps, 1); ps += __shfl_xor(ps, 2); ps += __shfl_xor(ps, 4); ps += __shfl_xor(ps, 8); ps += __shfl_xor(ps, 16);
        if ((tid & 31) == 0) rs[tt] = ps;
    }
}
__device__ __forceinline__ void gate_stage_x(LAS unsigned char* xbuf, int tid, const GatePre& R) {
    LAS bf16_t* VnT = (LAS bf16_t*)xbuf;
#pragma unroll
    for (int i = 0; i < 4; ++i) {
        const int item = tid + 512 * i, ss = item >> 4, oc = item & 15;
        const float mean = R.sq[i].x * (1.f / 512.f); const float var = fmaxf(R.sq[i].y * (1.f / 512.f) - mean * mean, 0.f); const float rstd = 1.f / sqrtf(var + EPS);
        const u32x4 x = R.xv[i];
        float v[8] = {bflo(x.x), bfhi(x.x), bflo(x.y), bfhi(x.y), bflo(x.z), bfhi(x.z), bflo(x.w), bfhi(x.w)};
        const int scol = ss + ((oc & 7) << 3);
#pragma unroll
        for (int e = 0; e < 8; ++e) VnT[(8 * oc + e) * GPX + scol] = (bf16_t)f2bf((v[e] - mean) * rstd);
    }
}
__device__ __forceinline__ void gate_compute(const Params& P, LAS unsigned char* lds, LAS unsigned char* xbuf, int l, int u, int tid, const u32x2 (&uw)[8]) {
    const int chunk = u >> 2, g = u & 3; const int lane = tid & 63, w = tid >> 6, fr = lane & 15, fq = lane >> 4;
    const LAS bf16_t* Wt = (const LAS bf16_t*)(lds + GATE_WT); const LAS float* rs = (const LAS float*)(lds + GATE_RS); const LAS bf16_t* VnT = (const LAS bf16_t*)xbuf;
    const int tt = 16 * w + fr;
    const float* lng = P.in[10] + l * 512 + g * 128 + 4 * fq; const float* lnb = P.in[11] + l * 512 + g * 128 + 4 * fq;
    f32x4 ga[8], be[8];
#pragma unroll
    for (int cb = 0; cb < 8; ++cb) { ga[cb] = *(const f32x4*)(lng + 16 * cb); be[cb] = *(const f32x4*)(lnb + 16 * cb); }
    const float bs = P.in[13][(size_t)(l * 4 + g) * 128 + tt];
    f32x4 acc[8];
#pragma unroll
    for (int cb = 0; cb < 8; ++cb) acc[cb] = (f32x4){0.f, 0.f, 0.f, 0.f};
    const LAS bf16_t* xlane = VnT + fr * GPX + 8 * fq + 8 * (fr >> 3);
#pragma unroll
    for (int ks = 0; ks < 4; ++ks) {
        const bf16x8 af = *(const LAS bf16x8*)(Wt + (16 * w + fr) * GP + 32 * ks + 8 * fq);
#pragma unroll
        for (int cb = 0; cb < 8; ++cb) {
            const bf16x8 bfv = *(const LAS bf16x8*)(xlane + (16 * cb * GPX + 16 * (cb & 3) + 32 * ks));
            acc[cb] = __builtin_amdgcn_mfma_f32_16x16x32_bf16(bfv, af, acc[cb], 0, 0, 0);
        }
    }
    const float rst = rs[tt];
    bf16_t* op = (bf16_t*)(P.ws + WS_R1) + ((size_t)chunk * 128 + tt) * MIXW + g * 128 + 4 * fq;
#pragma unroll
    for (int cb = 0; cb < 8; ++cb) {
        u32x2 ow; ow.x = pk2(bflo(uw[cb].x) * (ga[cb].x * acc[cb][0] + be[cb].x * rst + bs), bfhi(uw[cb].x) * (ga[cb].y * acc[cb][1] + be[cb].y * rst + bs));
        ow.y = pk2(bflo(uw[cb].y) * (ga[cb].z * acc[cb][2] + be[cb].z * rst + bs), bfhi(uw[cb].y) * (ga[cb].w * acc[cb][3] + be[cb].w * rst + bs));
        *(u32x2*)(op + 16 * cb) = ow;
    }
}
__device__ __forceinline__ void gate_prompt_loop(const Params& P, LAS unsigned char* lds, int l) {
    const int tid = opaque_tid(); const int G = gridDim.x;
    int u = opaque_bid();
    if (u >= 512) return;
    GatePre R; gate_prefetch(P, l, u, tid, R);
    int gcur = -1, buf = 0;
    for (;;) {
        if ((u & 3) != gcur) { if (gcur >= 0) __syncthreads(); gcur = u & 3; gate_stage_w(P, lds, l, gcur, tid); }
        u32x2 uc[8];
#pragma unroll
        for (int cb = 0; cb < 8; ++cb) uc[cb] = R.uw[cb];
        LAS unsigned char* xb = lds + GATE_XT + buf * GATE_XT_BYTES;
        gate_stage_x(xb, tid, R);
        const int un = u + G;
        if (un < 512) gate_prefetch(P, l, un, tid, R);
        __syncthreads();
        gate_compute(P, lds, xb, l, u, tid, uc);
        if (un >= 512) break;
        u = un; buf ^= 1;
    }
    __syncthreads();
}

__device__ __forceinline__ void sample_gc_unit(const Params& P, int l, int db) {
    const int tid = opaque_tid();
    const bf16_t* Z1 = (const bf16_t*)(P.ws + WS_Z1);
    const float* stats = (const float*)(P.ws + 65536) + (size_t)l * MR * 2;
    const size_t row0 = (size_t)(MPR + db * 4);
    const int c = tid, g = c >> 7;
    bf16_t* MIX = (bf16_t*)(P.ws + WS_R1);
    {
        const float lg = P.in[10][l * 512 + c], lb = P.in[11][l * 512 + c];
        float vn[4];
#pragma unroll
        for (int s = 0; s < 4; ++s) { const f32x2 sq = *(const f32x2*)(stats + (row0 + s) * 2);
            const float mean = sq.x * (1.f / 512.f); const float var = fmaxf(sq.y * (1.f / 512.f) - mean * mean, 0.f); const float rstd = 1.f / sqrtf(var + EPS);
            vn[s] = (bf1(Z1[ZB_GV + (row0 + s) * ZP_GV + c]) - mean) * rstd * lg + lb;
            P.out[O_AV + ((size_t)(l * 128 + db * 4 + s)) * 512 + c] = vn[s]; }
        const float* Wsrc = P.in[12] + (size_t)(l * 4 + g) * 128 * 128;
#pragma unroll
        for (int t = 0; t < 4; ++t) { float sa = P.in[13][(size_t)(l * 4 + g) * 128 + t];
#pragma unroll
            for (int s = 0; s < 4; ++s) if (s <= t) sa += Wsrc[t * 128 + s] * vn[s];
            MIX[(row0 + t) * MIXW + c] = (bf16_t)f2bf(bf1(Z1[ZB_U + (row0 + t) * ZP_U + c]) * sa); }
    }
    {
        float zp[6];
        zp[0] = P.in[4][((size_t)(l * 32 + db) * 2 + 0) * 512 + c]; zp[1] = P.in[4][((size_t)(l * 32 + db) * 2 + 1) * 512 + c];
#pragma unroll
        for (int t = 0; t < 4; ++t) zp[2 + t] = bf1(Z1[ZB_CC + (row0 + t) * ZP_CC + c]) * bf1(Z1[ZB_CX + (row0 + t) * ZP_CX + c]);
        const float w0 = P.in[14][(size_t)(l * 3 + 0) * 512 + c], w1 = P.in[14][(size_t)(l * 3 + 1) * 512 + c], w2 = P.in[14][(size_t)(l * 3 + 2) * 512 + c], cbias = P.in[15][l * 512 + c];
#pragma unroll
        for (int t = 0; t < 4; ++t) { const float conv = cbias + w0 * zp[t] + w1 * zp[t + 1] + w2 * zp[t + 2];
            MIX[(row0 + t) * MIXW + 768 + c] = (bf16_t)f2bf(bf1(Z1[ZB_CB + (row0 + t) * ZP_CB + c]) * conv); }
        P.out[O_CONVS + ((size_t)(l * 32 + db) * 2 + 0) * 512 + c] = zp[4];
        P.out[O_CONVS + ((size_t)(l * 32 + db) * 2 + 1) * 512 + c] = zp[5];
    }
}

__device__ __forceinline__ void conv_prompt_unit(const Params& P, int l, int rb) {
    const int tid = opaque_tid(), oc = tid & 63, rs = tid >> 6;
    const bf16_t* Z1 = (const bf16_t*)(P.ws + WS_Z1);
    bf16_t* MIX = (bf16_t*)(P.ws + WS_R1);
    const size_t row0 = (size_t)rb * 64 + rs * 8;
    const int s0 = (int)(row0 & (SEQ - 1)), bb = (int)(row0 >> 13);
    float w0[8], w1[8], w2[8], cbias[8], zm2[8], zm1[8];
    { const float* cw = P.in[14] + (size_t)l * 3 * 512 + 8 * oc; const float* cbp = P.in[15] + l * 512 + 8 * oc;
      const f32x4 a0 = *(const f32x4*)cw, a1 = *(const f32x4*)(cw + 4), b0 = *(const f32x4*)(cw + 512), b1 = *(const f32x4*)(cw + 516), c0 = *(const f32x4*)(cw + 1024), c1 = *(const f32x4*)(cw + 1028), d0 = *(const f32x4*)cbp, d1 = *(const f32x4*)(cbp + 4);
#pragma unroll
      for (int e = 0; e < 4; ++e) { w0[e] = a0[e]; w0[4 + e] = a1[e]; w1[e] = b0[e]; w1[4 + e] = b1[e]; w2[e] = c0[e]; w2[4 + e] = c1[e]; cbias[e] = d0[e]; cbias[4 + e] = d1[e]; } }
#pragma unroll
    for (int e = 0; e < 8; ++e) { zm2[e] = 0.f; zm1[e] = 0.f; }
    if (s0 >= 2) {
        const u32x4 a2 = *(const u32x4*)(Z1 + ZB_CC + (row0 - 2) * ZP_CC + 8 * oc), b2 = *(const u32x4*)(Z1 + ZB_CX + (row0 - 2) * ZP_CX + 8 * oc);
        const u32x4 a1 = *(const u32x4*)(Z1 + ZB_CC + (row0 - 1) * ZP_CC + 8 * oc), b1 = *(const u32x4*)(Z1 + ZB_CX + (row0 - 1) * ZP_CX + 8 * oc);
        zm2[0] = bflo(a2.x) * bflo(b2.x); zm2[1] = bfhi(a2.x) * bfhi(b2.x); zm2[2] = bflo(a2.y) * bflo(b2.y); zm2[3] = bfhi(a2.y) * bfhi(b2.y);
        zm2[4] = bflo(a2.z) * bflo(b2.z); zm2[5] = bfhi(a2.z) * bfhi(b2.z); zm2[6] = bflo(a2.w) * bflo(b2.w); zm2[7] = bfhi(a2.w) * bfhi(b2.w);
        zm1[0] = bflo(a1.x) * bflo(b1.x); zm1[1] = bfhi(a1.x) * bfhi(b1.x); zm1[2] = bflo(a1.y) * bflo(b1.y); zm1[3] = bfhi(a1.y) * bfhi(b1.y);
        zm1[4] = bflo(a1.z) * bflo(b1.z); zm1[5] = bfhi(a1.z) * bfhi(b1.z); zm1[6] = bflo(a1.w) * bflo(b1.w); zm1[7] = bfhi(a1.w) * bfhi(b1.w);
    }
#pragma unroll
    for (int i = 0; i < 8; ++i) {
        const size_t row = row0 + i;
        const u32x4 a = *(const u32x4*)(Z1 + ZB_CC + row * ZP_CC + 8 * oc), b = *(const u32x4*)(Z1 + ZB_CX + row * ZP_CX + 8 * oc), cbv = *(const u32x4*)(Z1 + ZB_CB + row * ZP_CB + 8 * oc);
        float z[8] = {bflo(a.x) * bflo(b.x), bfhi(a.x) * bfhi(b.x), bflo(a.y) * bflo(b.y), bfhi(a.y) * bfhi(b.y), bflo(a.z) * bflo(b.z), bfhi(a.z) * bfhi(b.z), bflo(a.w) * bflo(b.w), bfhi(a.w) * bfhi(b.w)};
        float cbf[8] = {bflo(cbv.x), bfhi(cbv.x), bflo(cbv.y), bfhi(cbv.y), bflo(cbv.z), bfhi(cbv.z), bflo(cbv.w), bfhi(cbv.w)};
        float oo[8];
#pragma unroll
        for (int e = 0; e < 8; ++e) { oo[e] = cbf[e] * (cbias[e] + w0[e] * zm2[e] + w1[e] * zm1[e] + w2[e] * z[e]); zm2[e] = zm1[e]; zm1[e] = z[e]; }
        u32x4 ow; ow.x = pk2(oo[0], oo[1]); ow.y = pk2(oo[2], oo[3]); ow.z = pk2(oo[4], oo[5]); ow.w = pk2(oo[6], oo[7]);
        *(u32x4*)(MIX + row * MIXW + 768 + 8 * oc) = ow;
        const int sp = s0 + i;
        if (sp >= SEQ - 2) { float* dst = P.out + O_CONVP + ((size_t)(l * 2 + bb) * 2 + (sp - (SEQ - 2))) * 512 + 8 * oc;
            *(f32x4*)dst = (f32x4){z[0], z[1], z[2], z[3]}; *(f32x4*)(dst + 4) = (f32x4){z[4], z[5], z[6], z[7]}; }
    }
}

__device__ __forceinline__ void phase_mixer(const Params& P, LAS unsigned char* lds, int l, int mask = 31) {
    const int bid = opaque_bid(), G = gridDim.x;
    if (mask & 1) { const int wv = __builtin_amdgcn_readfirstlane(opaque_tid() >> 6); const int wu0 = wv * G + bid; if (wu0 < 3072) attn_sample_wave(P, l, wu0); if (wu0 + 8 * G < 3072) attn_sample_wave(P, l, wu0 + 8 * G);
        if (G < 192) for (int wu = wu0 + 16 * G; wu < 3072; wu += G * 8) attn_sample_wave(P, l, wu); }
    const bool conv_first = (bid & 1) == 0;
    if (conv_first) { if (mask & 2) for (int u = bid; u < 32; u += G) sample_gc_unit(P, l, u);
                      if (mask & 16) for (int u = bid; u < 256; u += G) conv_prompt_unit(P, l, u); }
    if (mask & 4) gate_prompt_loop(P, lds, l);
    if (mask & 8) attn_prompt_loop(P, lds);
    if (!conv_first) { if (mask & 2) for (int u = bid; u < 32; u += G) sample_gc_unit(P, l, u);
                       if (mask & 16) for (int u = bid; u < 256; u += G) conv_prompt_unit(P, l, u); }
}

__device__ __forceinline__ void phase_combine(const Params& P) {
    const bf16_t* og = (const bf16_t*)(P.ws + WS_R3); const float* lse = (const float*)(P.ws + WS_R3 + R3_LSE);
    bf16_t* MIX = (bf16_t*)(P.ws + WS_R1);
    const int nth = gridDim.x * 512; const int gtid = opaque_bid() * 512 + opaque_tid();
    if (gtid < 128 * 64) {
        const int rt = gtid >> 6, h = (gtid >> 4) & 3, dq = (gtid & 15) * 4;
        const float* ml = (const float*)(P.ws + WS_R3 + R3_SPML) + (size_t)rt * SPN * 8 + h * 2;
        const float* spo = (const float*)(P.ws + WS_R3 + R3_SPO) + (size_t)rt * SPN * 256 + h * 64 + dq;
        float M = -INFINITY;
#pragma unroll
        for (int i = 0; i < SPN; ++i) M = fmaxf(M, ml[i * 8]);
        f32x4 acc = (f32x4){0.f, 0.f, 0.f, 0.f}; float L = 0.f;
#pragma unroll
        for (int i = 0; i < SPN; ++i) { const float f = __expf(ml[i * 8] - M); L += f * ml[i * 8 + 1]; acc += *(const f32x4*)(spo + i * 256) * f; }
        const float rl = 1.f / L;
        u32x2 ow; ow.x = pk2(acc.x * rl, acc.y * rl); ow.y = pk2(acc.z * rl, acc.w * rl);
        *(u32x2*)(MIX + (size_t)(MPR + rt) * MIXW + 512 + h * 64 + dq) = ow;
    }
    for (int idx = gtid; idx < MPR * 32; idx += nth) {
        const int part = idx & 7, h = (idx >> 3) & 3; const size_t row = (size_t)(idx >> 5);
        const float l0 = lse[(0 * (size_t)MPR + row) * 4 + h], l1 = lse[(1 * (size_t)MPR + row) * 4 + h], l2 = lse[(2 * (size_t)MPR + row) * 4 + h];
        const float m = fmaxf(l0, fmaxf(l1, l2));
        float w0 = __expf(l0 - m), w1 = __expf(l1 - m), w2 = __expf(l2 - m); const float rs = 1.f / (w0 + w1 + w2); w0 *= rs; w1 *= rs; w2 *= rs;
        const u32x4 a = *(const u32x4*)(og + (0 * (size_t)MPR + row) * 256 + h * 64 + 8 * part);
        const u32x4 b = *(const u32x4*)(og + (1 * (size_t)MPR + row) * 256 + h * 64 + 8 * part);
        const u32x4 c = *(const u32x4*)(og + (2 * (size_t)MPR + row) * 256 + h * 64 + 8 * part);
        u32x4 o;
        o.x = pk2(w0 * bflo(a.x) + w1 * bflo(b.x) + w2 * bflo(c.x), w0 * bfhi(a.x) + w1 * bfhi(b.x) + w2 * bfhi(c.x));
        o.y = pk2(w0 * bflo(a.y) + w1 * bflo(b.y) + w2 * bflo(c.y), w0 * bfhi(a.y) + w1 * bfhi(b.y) + w2 * bfhi(c.y));
        o.z = pk2(w0 * bflo(a.z) + w1 * bflo(b.z) + w2 * bflo(c.z), w0 * bfhi(a.z) + w1 * bfhi(b.z) + w2 * bfhi(c.z));
        o.w = pk2(w0 * bflo(a.w) + w1 * bflo(b.w) + w2 * bflo(c.w), w0 * bfhi(a.w) + w1 * bfhi(b.w) + w2 * bfhi(c.w));
        *(u32x4*)(MIX + row * MIXW + 512 + h * 64 + 8 * part) = o;
    }
}

template <bool B> __device__ __forceinline__ void phase_rows(const Params& P, const bf16_t* mix, const bf16_t* ffn, bool x_from_input, const float* g1, const float* g2, const float* g3, const float* gnext) {
    const int tid = opaque_tid(), lane = tid & 63, wave = tid >> 6;
    const int gw = opaque_bid() * 8 + wave, NGW = gridDim.x * 8;
    bf16_t* H = (bf16_t*)(P.ws + WS_R1);
    for (int m = gw; m < MR; m += NGW) {
        const float* xr = x_from_input ? (m < MPR ? P.in[0] + (size_t)m * DM : P.in[1] + (size_t)(m - MPR) * DM) : P.out + (size_t)m * DM;
        f32x4 mv[4], xv[4], fv[4]; float s = 0.f, sf = 0.f;
#pragma unroll
        for (int j = 0; j < 4; ++j) { const u32x2 mw = *(const u32x2*)(mix + (size_t)m * DM + 4 * lane + 256 * j); mv[j] = (f32x4){bflo(mw.x), bfhi(mw.x), bflo(mw.y), bfhi(mw.y)};
            xv[j] = *(const f32x4*)(xr + 4 * lane + 256 * j); s += (mv[j].x * mv[j].x + mv[j].y * mv[j].y) + (mv[j].z * mv[j].z + mv[j].w * mv[j].w);
            if (B) { const u32x2 fw = *(const u32x2*)(ffn + (size_t)m * DM + 4 * lane + 256 * j); fv[j] = (f32x4){bflo(fw.x), bfhi(fw.x), bflo(fw.y), bfhi(fw.y)};
                sf += (fv[j].x * fv[j].x + fv[j].y * fv[j].y) + (fv[j].z * fv[j].z + fv[j].w * fv[j].w); } }
        const float r = 1.f / sqrtf(wave_sum(s) * (1.f / DM) + EPS);
        float rf = 0.f; if (B) rf = 1.f / sqrtf(wave_sum(sf) * (1.f / DM) + EPS);
        float s2 = 0.f;
#pragma unroll
        for (int j = 0; j < 4; ++j) { const f32x4 gg = *(const f32x4*)(g1 + 4 * lane + 256 * j); xv[j] = xv[j] + mv[j] * r * gg;
            if (B) { const f32x4 g3v = *(const f32x4*)(g3 + 4 * lane + 256 * j); xv[j] = xv[j] + fv[j] * rf * g3v; *(f32x4*)(P.out + (size_t)m * DM + 4 * lane + 256 * j) = xv[j]; }
            s2 += (xv[j].x * xv[j].x + xv[j].y * xv[j].y) + (xv[j].z * xv[j].z + xv[j].w * xv[j].w); }
        const float* gn = B ? gnext : g2;
        if (gn) {
            const float r2 = 1.f / sqrtf(wave_sum(s2) * (1.f / DM) + EPS);
#pragma unroll
            for (int j = 0; j < 4; ++j) { const f32x4 gg = *(const f32x4*)(gn + 4 * lane + 256 * j);
                u32x2 o; o.x = pk2(xv[j].x * r2 * gg.x, xv[j].y * r2 * gg.y); o.y = pk2(xv[j].z * r2 * gg.z, xv[j].w * r2 * gg.w);
                *(u32x2*)(H + (size_t)m * DM + 4 * lane + 256 * j) = o; }
        }
    }
}

template <int NSTEP> __device__ __forceinline__ void mini_acc(f32x4& acc, const bf16_t* ap, const bf16_t* bp) {
    bf16x8 a[NSTEP], b[NSTEP];
#pragma unroll
    for (int i = 0; i < NSTEP; ++i) { a[i] = *(const bf16x8*)(ap + 32 * i); b[i] = *(const bf16x8*)(bp + 32 * i); }
#pragma unroll
    for (int i = 0; i < NSTEP; ++i) acc = __builtin_amdgcn_mfma_f32_16x16x32_bf16(b[i], a[i], acc, 0, 0, 0);
}
template <int MODE> __device__ __forceinline__ void sample_gemm(LAS unsigned char* lds, const bf16_t* A, const bf16_t* Bt, bf16_t* O, const bf16_t* G) {
    const int tid = opaque_tid(), lane = tid & 63, w = tid >> 6, fr = lane & 15, fq = lane >> 4, kq = w & 3, half = w >> 2;
    LAS f32x4* red = (LAS f32x4*)lds;
    constexpr int LDA = MODE == 0 ? DM : (MODE == 1 ? FF : MIXW);
    for (int tile = opaque_bid() * 2 + half; tile < 512; tile += 2 * gridDim.x) {
        const int rb = tile >> 6, cb = tile & 63;
        const size_t row = (size_t)(MPR + 16 * rb + fr); const int col = 16 * cb + fr;
        const bf16_t* ap = A + row * LDA + 8 * fq; const bf16_t* bp = Bt + (size_t)col * LDA + 8 * fq;
        f32x4 acc = (f32x4){0.f, 0.f, 0.f, 0.f};
        const size_t orow = (size_t)(MPR + 16 * rb + fr); const int ocol = 16 * cb + 4 * fq;
        if constexpr (MODE == 0) { mini_acc<8>(acc, ap + 256 * kq, bp + 256 * kq); }
        else if constexpr (MODE == 1) { mini_acc<11>(acc, ap + 704 * kq, bp + 704 * kq); mini_acc<11>(acc, ap + 704 * kq + 352, bp + 704 * kq + 352); }
        else {
            f32x4 a0 = (f32x4){0.f, 0.f, 0.f, 0.f}, a1 = a0, a2 = a0;
            mini_acc<4>(a0, ap + 128 * kq, bp + 128 * kq);
            mini_acc<2>(a1, ap + 512 + 64 * kq, bp + 512 + 64 * kq);
            mini_acc<4>(a2, ap + 768 + 128 * kq, bp + 768 + 128 * kq);
            const bf16_t* gp = G + orow * GW + ocol;
            const u32x2 g0 = *(const u32x2*)gp, g1 = *(const u32x2*)(gp + DM), g2 = *(const u32x2*)(gp + 2 * DM);
            acc[0] = a0[0] * bflo(g0.x) + a1[0] * bflo(g1.x) + a2[0] * bflo(g2.x);
            acc[1] = a0[1] * bfhi(g0.x) + a1[1] * bfhi(g1.x) + a2[1] * bfhi(g2.x);
            acc[2] = a0[2] * bflo(g0.y) + a1[2] * bflo(g1.y) + a2[2] * bflo(g2.y);
            acc[3] = a0[3] * bfhi(g0.y) + a1[3] * bfhi(g1.y) + a2[3] * bfhi(g2.y);
        }
        if (kq > 0) red[(half * 3 + kq - 1) * 64 + lane] = acc;
        __syncthreads();
        if (kq == 0) {
            acc += red[(half * 3 + 0) * 64 + lane]; acc += red[(half * 3 + 1) * 64 + lane]; acc += red[(half * 3 + 2) * 64 + lane];
            u32x2 ow; ow.x = pk2(acc[0], acc[1]); ow.y = pk2(acc[2], acc[3]);
            *(u32x2*)(O + orow * DM + ocol) = ow;
        }
        __syncthreads();
    }
}

#define XB_TMO      128
#define XB_XCNT(j)  (256  + 64 * (j))
#define XB_XSUB(j)  (1280 + 64 * (j))
#define XB_XGEN(j)  (2304 + 64 * (j))
#define XB_TOP      3328
#define XB_TOPGEN   3392
#define XCD_BAR_WORDS 3456
#define XB_SPIN_CAP (1u << 18)
__device__ __forceinline__ unsigned xb_ld(unsigned* p)              { return __hip_atomic_load(p, __ATOMIC_RELAXED, __HIP_MEMORY_SCOPE_AGENT); }
__device__ __forceinline__ unsigned xb_add(unsigned* p, unsigned v) { return __hip_atomic_fetch_add(p, v, __ATOMIC_RELAXED, __HIP_MEMORY_SCOPE_AGENT); }
__device__ __forceinline__ unsigned xb_xcc_id() { return (unsigned)__builtin_amdgcn_s_getreg((3 << 11) | 20) & 0xFu; }
#define XB_SPIN(cond, bar) do { unsigned _sp = 0; while (cond) { __builtin_amdgcn_s_sleep(1); \
    if ((++_sp & 255u) == 0u) { if (xb_ld(&(bar)[XB_TMO])) break; if (_sp > XB_SPIN_CAP) { atomicAdd(&(bar)[XB_TMO], 1u); break; } } } } while (0)
struct XcdBarrier { unsigned* bar; unsigned x; volatile LAS unsigned* st; };
__device__ __forceinline__ XcdBarrier xcd_barrier_post(unsigned* bar, volatile LAS unsigned* st) {
    XcdBarrier b; b.bar = bar; b.x = xb_xcc_id(); b.st = st;
    if (threadIdx.x == 0) (void)xb_add(&bar[XB_XCNT(b.x)], 1u);
    return b;
}
__device__ __forceinline__ void xcd_barrier_complete(unsigned* bar, unsigned x, unsigned& nloc, unsigned& nx) {
    const unsigned G = gridDim.x * gridDim.y * gridDim.z;
    unsigned sum, cnt, mine, sp = 0u;
    for (;;) {
        sum = 0u; cnt = 0u; mine = 0u;
#pragma unroll
        for (unsigned j = 0; j < 16; ++j) { const unsigned c = xb_ld(&bar[XB_XCNT(j)]); sum += c; cnt += (c > 0u) ? 1u : 0u; mine = (j == x) ? c : mine; }
        if (sum == G) break;
        __builtin_amdgcn_s_sleep(1);
        if ((++sp & 255u) == 0u) { if (xb_ld(&bar[XB_TMO])) break; if (sp > XB_SPIN_CAP) { atomicAdd(&bar[XB_TMO], 1u); break; } }
    }
    nloc = mine > 0u ? mine : 1u; nx = cnt > 0u ? cnt : 1u;
}
__device__ __forceinline__ void xcd_barrier(const XcdBarrier& b) {
    asm volatile("s_waitcnt vmcnt(0)" ::: "memory");
    __syncthreads();
    if (threadIdx.x == 0) {
        unsigned* bar = b.bar;
        __builtin_amdgcn_s_waitcnt(0);
        unsigned nloc = b.st[0], nx = b.st[1];
        if (nloc == 0u) { xcd_barrier_complete(bar, b.x, nloc, nx); b.st[0] = nloc; b.st[1] = nx; }
        const unsigned old = xb_add(&bar[XB_XSUB(b.x)], 1u);
        const unsigned gen = old / nloc;
        if (old + 1u == (gen + 1u) * nloc) {
            __builtin_amdgcn_fence(__ATOMIC_RELEASE, "agent");
            asm volatile("s_waitcnt vmcnt(0)" ::: "memory");
            const unsigned og = xb_add(&bar[XB_TOP], 1u);
            const unsigned tg = og / nx;
            if (og + 1u == (tg + 1u) * nx) xb_add(&bar[XB_TOPGEN], 1u);
            else XB_SPIN(xb_ld(&bar[XB_TOPGEN]) == tg, bar);
            __builtin_amdgcn_fence(__ATOMIC_ACQUIRE, "agent");
            xb_add(&bar[XB_XGEN(b.x)], 1u);
            asm volatile("s_waitcnt vmcnt(0)" ::: "memory");
        } else {
            XB_SPIN(xb_ld(&bar[XB_XGEN(b.x)]) == gen, bar);
            __builtin_amdgcn_fence(__ATOMIC_ACQUIRE, "agent");
            asm volatile("s_waitcnt vmcnt(0)" ::: "memory");
        }
    }
    __syncthreads();
}

constexpr int PH_PER_LAYER = 9, N_PHASES = 1 + 2 * PH_PER_LAYER;
template <int PH> __device__ __forceinline__ void do_phase(const Params& P, LAS unsigned char* lds) {
    if constexpr (PH == 0) { phase_prologue(P, lds); }
    else {
        constexpr int l = (PH - 1) / PH_PER_LAYER, k = (PH - 1) % PH_PER_LAYER;
        const int G = gridDim.x;
        unsigned char* wl = P.ws + WS_W + (size_t)l * W_LAYER;
        bf16_t* R1 = (bf16_t*)(P.ws + WS_R1); bf16_t* R2 = (bf16_t*)(P.ws + WS_R2); bf16_t* R3 = (bf16_t*)(P.ws + WS_R3);
        bf16_t* Z1 = (bf16_t*)(P.ws + WS_Z1); bf16_t* GB = (bf16_t*)(P.ws + WS_G);
        pg8::StaticOrder S;
        if constexpr (k == 0) {
            pg8::Gemm g{R1, (const bf16_t*)(wl + WO_IN)}; S.init(MPAD, INW, G, opaque_bid());
            pg8::EpiIn E{Z1, GB, P.in[19] + (size_t)l * GW, P.out + O_KWIN + (size_t)l * 1048576, P.out + O_VWIN + (size_t)l * 1048576, P.out + O_KROW + (size_t)l * 32768, P.out + O_VROW + (size_t)l * 32768, (float*)(P.ws + 65536) + (size_t)l * MR * 2};
            pg8::gemm_phase<pg8::EpiIn, true, DM, DM, DM>(lds, g, S, E);
            if constexpr (l == 0) { const int nwg = (MPAD / 256) * (INW / 256); const int rounds = (nwg + G - 1) / G; const int nf = nwg - (rounds - 1) * G; const int b = opaque_bid();
                if (defer_layer1(G)) { if (G - nf >= 16) { if (b >= nf) convert_items(P, lds, 1, (b - nf) * 8 + (opaque_tid() >> 6), (G - nf) * 8, CV_SPLIT); }
                    else convert_items(P, lds, 1, b * 8 + (opaque_tid() >> 6), G * 8, CV_SPLIT); } }
        } else if constexpr (k == 1) { phase_mixer(P, lds, l); }
        else if constexpr (k == 2) { phase_combine(P); }
        else if constexpr (k == 3) {
            S.init(MPR, DM, G, opaque_bid()); pg8::Gemm g{R1, (const bf16_t*)(wl + WO_BR)}; pg8::EpiGated E{GB, R2};
            pg8::gemm_phase<pg8::EpiGated, true, MIXW, MIXW, MIXW>(lds, g, S, E);
            sample_gemm<2>(lds, R1, (const bf16_t*)(wl + WO_BR), R2, GB);
        } else if constexpr (k == 4) {
            pg8::Gemm g{R2, (const bf16_t*)(wl + WO_O)}; S.init(MPR, DM, G, opaque_bid());
            pg8::EpiBf16 E{R3, DM};
            pg8::gemm_phase<pg8::EpiBf16, true, DM, DM, DM>(lds, g, S, E);
            sample_gemm<0>(lds, R2, (const bf16_t*)(wl + WO_O), R3, nullptr);
        } else if constexpr (k == 5) { phase_rows<false>(P, R3, nullptr, l == 0, P.in[6] + (size_t)l * DM, P.in[7] + (size_t)l * DM, nullptr, nullptr); }
        else if constexpr (k == 6) {
            pg8::Gemm g{R1, (const bf16_t*)(wl + WO_GU)}; S.init(MPAD, 2 * FF, G, opaque_bid());
            pg8::EpiSwiglu E{Z1};
            pg8::gemm_phase<pg8::EpiSwiglu, true, DM, DM, DM>(lds, g, S, E);
            if constexpr (l == 0) { const int nf = up_full_blocks(G); const int b = opaque_bid();
                if (defer_layer1(G) && b >= nf) convert_items(P, lds, 1, CV_SPLIT + (b - nf) * 8 + (opaque_tid() >> 6), (G - nf) * 8); }
        } else if constexpr (k == 7) {
            pg8::Gemm g{Z1, (const bf16_t*)(wl + WO_D)}; S.init(MPR, DM, G, opaque_bid());
            pg8::EpiBf16 E{R2, DM};
            pg8::gemm_phase<pg8::EpiBf16, true, FF, FF, FF>(lds, g, S, E);
            sample_gemm<1>(lds, Z1, (const bf16_t*)(wl + WO_D), R2, nullptr);
        } else { phase_rows<true>(P, R3, R2, l == 0, P.in[6] + (size_t)l * DM, nullptr, P.in[8] + (size_t)l * DM, l + 1 < 2 ? P.in[5] + (size_t)(l + 1) * DM : nullptr); }
    }
    __syncthreads();
}

#ifndef PH_MASK
#define PH_MASK 0x7ffff
#endif
#ifndef PROBE_DUP
#define PROBE_DUP 0
#endif
#ifndef PROBE_MIX
#define PROBE_MIX 0
#endif
#ifndef PROBE_SYNCS
#define PROBE_SYNCS 0
#endif
__global__ void __launch_bounds__(512, 2) fwd_kernel(Params P) {
    extern __shared__ __attribute__((aligned(16))) unsigned char lds_raw[];
    LAS unsigned char* lds = (LAS unsigned char*)lds_raw;
    cg::grid_group grid = cg::this_grid();
    volatile LAS unsigned* stw = (volatile LAS unsigned*)(lds + LDS_BYTES - 64);
    if (threadIdx.x < 4) stw[threadIdx.x] = 0u;
    __syncthreads();
    XcdBarrier bar; bar.bar = (unsigned*)P.ws; bar.x = 0; bar.st = stw;
    if (P.ph_hi - P.ph_lo > 1) bar = xcd_barrier_post((unsigned*)P.ws, stw);
    if (P.ph_hi < 0) grid.sync();
#define RUN(ph) if (((PH_MASK >> ph) & 1) && P.ph_lo <= ph && ph < P.ph_hi) { if (ph > P.ph_lo) xcd_barrier(bar); do_phase<ph>(P, lds); if ((PROBE_DUP >> ph) & 1) { xcd_barrier(bar); do_phase<ph>(P, lds); } }
    for (int i = 0; i < PROBE_SYNCS; ++i) xcd_barrier(bar);
    RUN(0) RUN(1) RUN(2)
    if (PROBE_MIX) { xcd_barrier(bar); phase_mixer(P, lds, 0, PROBE_MIX); }
    RUN(3) RUN(4) RUN(5) RUN(6) RUN(7) RUN(8) RUN(9) RUN(10) RUN(11) RUN(12) RUN(13) RUN(14) RUN(15) RUN(16) RUN(17) RUN(18)
#undef RUN
}

extern "C" void kernel_launch(void* const* d_in, const int* in_sizes, int n_in, void* d_out, int out_size, void* d_ws, size_t ws_size, hipStream_t stream) {
    static int grid = 0;
    if (grid == 0) {
        int dev = 0, cus = 0, per_cu = 0;
        (void)hipGetDevice(&dev);
        (void)hipDeviceGetAttribute(&cus, hipDeviceAttributeMultiprocessorCount, dev);
        (void)hipFuncSetAttribute((const void*)fwd_kernel, hipFuncAttributeMaxDynamicSharedMemorySize, LDS_BYTES);
        (void)hipOccupancyMaxActiveBlocksPerMultiprocessor(&per_cu, (const void*)fwd_kernel, 512, LDS_BYTES);
        if (per_cu < 1) per_cu = 1;
        (void)hipGetLastError();
        grid = cus * 1;
        if (n_in != 24 || ws_size < WS_END) { fprintf(stderr, "kernel_launch: unexpected n_in %d / ws_size %zu\n", n_in, ws_size); }
    }
    (void)hipMemsetAsync(d_ws, 0, 524288, stream);
    Params p{};
    for (int i = 0; i < 24; ++i) p.in[i] = (const float*)d_in[i];
    p.out = (float*)d_out; p.ws = (unsigned char*)d_ws;
#if ONE_LAUNCH
    p.ph_lo = 0; p.ph_hi = N_PHASES;
    void* args[] = {&p};
    hipError_t e = hipLaunchCooperativeKernel((const void*)fwd_kernel, dim3(grid), dim3(512), args, LDS_BYTES, stream);
    if (e != hipSuccess) fprintf(stderr, "cooperative launch failed: %s (grid %d)\n", hipGetErrorString(e), grid);
#else
    for (int ph = 0; ph < N_PHASES; ++ph) {
        p.ph_lo = ph; p.ph_hi = ph + 1;
        hipLaunchKernelGGL(fwd_kernel, dim3(grid), dim3(512), LDS_BYTES, stream, p);
    }
#endif
}
```

```cpp
#include <hip/hip_runtime.h>
#include <hip/hip_cooperative_groups.h>
#include <cstdio>
#include <cstdint>
namespace cg = cooperative_groups;

#ifndef ONE_LAUNCH
#define ONE_LAUNCH 1
#endif

#define LAS __attribute__((address_space(3)))
typedef unsigned short bf16_t;
typedef short bf16x8 __attribute__((ext_vector_type(8)));
typedef short bf16x4 __attribute__((ext_vector_type(4)));
typedef float f32x4 __attribute__((ext_vector_type(4)));
typedef float f32x2 __attribute__((ext_vector_type(2)));
typedef unsigned u32x4 __attribute__((ext_vector_type(4)));
typedef unsigned u32x2 __attribute__((ext_vector_type(2)));

constexpr int DM = 1024, SEQ = 8192, MPR = 16384, MSM = 128, MR = MPR + MSM, MPAD = 16640;
constexpr int INW = 6912, ZW = 3840, GW = 3072, FF = 2816, MIXW = 1280;
constexpr size_t ZB_U = 0, ZB_GV = (size_t)MPAD * 512, ZB_Q = (size_t)MPAD * 1024, ZB_K = (size_t)MPAD * 1792, ZB_V = (size_t)MPAD * 2048, ZB_CX = (size_t)MPAD * 2304, ZB_CB = (size_t)MPAD * 2816, ZB_CC = (size_t)MPAD * 3328;
constexpr int KVP = 576;
constexpr size_t ZP_U = 512, ZP_GV = 512, ZP_Q = 768, ZP_K = 256, ZP_V = 256, ZP_CX = 512, ZP_CB = 512, ZP_CC = 512;
constexpr float EPS = 1e-6f;
constexpr size_t O_Y = 0, O_KWIN = 16908288, O_VWIN = 19005440, O_KROW = 21102592, O_VROW = 21168128, O_CONVP = 21233664, O_CONVS = 21237760, O_AV = 21303296;
constexpr size_t MiB = 1u << 20;
constexpr size_t WS_W = 1 * MiB, W_LAYER = 36 * MiB;
constexpr size_t WO_IN = 0, WO_BR = 14155776, WO_O = WO_BR + 2621440, WO_GU = WO_O + 2097152, WO_D = WO_GU + 11534336;
static_assert(WO_D + 5767168 <= W_LAYER, "weights");
constexpr size_t WS_R1 = 73 * MiB;
constexpr size_t WS_R2 = 114 * MiB;
constexpr size_t WS_R3 = 147 * MiB;
constexpr size_t WS_Z1 = 180 * MiB;
constexpr size_t WS_G = 302 * MiB;
constexpr size_t WS_END = 400 * MiB;
constexpr size_t R3_LSE = (size_t)3 * MPR * 256 * 2;

constexpr int LDS_BYTES = 147456;

__device__ __forceinline__ unsigned f2bf(float f) { unsigned u = __builtin_bit_cast(unsigned, f); return (u + 0x7fffu + ((u >> 16) & 1u)) >> 16; }
typedef __bf16 bf16x2_t __attribute__((ext_vector_type(2)));
__device__ __forceinline__ unsigned pk2(float lo, float hi) { f32x2 v = {lo, hi}; bf16x2_t b = __builtin_convertvector(v, bf16x2_t); return __builtin_bit_cast(unsigned, b); }
__device__ __forceinline__ float bflo(unsigned w) { return __builtin_bit_cast(float, w << 16); }
__device__ __forceinline__ float bfhi(unsigned w) { return __builtin_bit_cast(float, w & 0xffff0000u); }
__device__ __forceinline__ float bf1(bf16_t b) { return __builtin_bit_cast(float, (unsigned)b << 16); }
__device__ __forceinline__ float sigm(float x) { return __builtin_amdgcn_rcpf(1.f + __expf(-x)); }
__device__ __forceinline__ float gelu_t(float x) { return x * sigm(1.5957691216057308f * x * (1.f + 0.044715f * x * x)); }
__device__ __forceinline__ float wave_sum(float v) {
#pragma unroll
    for (int o = 1; o < 64; o <<= 1) v += __shfl_xor(v, o);
    return v;
}
__device__ __forceinline__ int opaque_bid() { int b = blockIdx.x; asm volatile("" : "+s"(b)); return b; }
__device__ __forceinline__ int opaque_tid() { int t = threadIdx.x; asm volatile("" : "+v"(t)); return t; }
#define LDS_WAIT() asm volatile("s_waitcnt lgkmcnt(0)" ::: "memory")

namespace pg8 {
constexpr int BM = 256, BK = 64, HALF = 128, HTB = HALF * BK * 2, STAGE_BYTES = 8 * HTB, NXCD = 8, WGM = 4;
__host__ __device__ __forceinline__ int lds_byte(int r, int c) { const int st = (r >> 4) * 2 + (c >> 5), rr = r & 15, cc = c & 31, ob = rr * 64 + cc * 2; return st * 1024 + (ob ^ (((ob >> 9) & 1) << 5)); }
__host__ __device__ __forceinline__ void stage_rc(int b, int& R, int& C) { const int st = b / 1024, sb = b % 1024, swz = sb ^ (((sb >> 9) & 1) << 5); R = (st >> 1) * 16 + swz / 64; C = (st & 1) * 32 + (swz % 64) / 2; }
__host__ __device__ __forceinline__ int perm32(int rho) { const int n = rho >> 4, i = rho & 15; return 8 * (i >> 2) + 4 * n + (i & 3); }

struct Unit { int pm, pn; };
struct Gemm { const bf16_t* A; const bf16_t* Bt; };

struct StaticOrder {
    int nM, nN, nwg, G, c;
    __host__ __device__ void init(int M, int N, int G_, int c_) { nM = M / BM; nN = N / BM; nwg = nM * nN; G = G_; c = c_; }
    __host__ __device__ bool next(int i, Unit& u) const {
        const long L = (long)i * G + c; if (L >= nwg) return false;
        int wgid = (int)L; { const int q = nwg / NXCD, r = nwg % NXCD, xcd = wgid % NXCD, off = wgid / NXCD; wgid = (xcd < r ? xcd * (q + 1) : r * (q + 1) + (xcd - r) * q) + off; }
        const int nig = WGM * nN, gid = wgid / nig, fm = gid * WGM, gsz = (nM - fm) < WGM ? (nM - fm) : WGM;
        u.pm = fm + ((wgid % nig) % gsz); u.pn = (wgid % nig) / gsz; return true;
    }
};

template <class Epi, bool ALIGN_EPI, int K_, int LDA_, int LDB_>
__device__ __forceinline__ void gemm_phase(LAS unsigned char* lds, const Gemm g, const StaticOrder& S, const Epi& E) {
    int tid_ = threadIdx.x; asm volatile("" : "+v"(tid_));
    const int tid = tid_, wid = __builtin_amdgcn_readfirstlane(tid >> 6), lane = tid & 63, wr = wid >> 2, wc = wid & 3, fr = lane & 15, fq = lane >> 4;
    constexpr int nt = K_ / BK;
    unsigned voffA[2], voffB[2];
#pragma unroll
    for (int i = 0; i < 2; ++i) { int R, C; stage_rc(tid * 16 + i * 8192, R, C); const int Rb = Epi::PERM ? ((R & ~31) + perm32(R & 31)) : R;
        voffA[i] = (unsigned)(R * LDA_ + C) * 2u; voffB[i] = (unsigned)(Rb * LDB_ + C) * 2u; }
    constexpr size_t kstep = (size_t)(BK * 2);
    constexpr size_t hstepA = (size_t)HALF * LDA_ * 2, hstepB = (size_t)HALF * LDB_ * 2;
    constexpr size_t tstepA = 2 * hstepA, tstepB = 2 * hstepB;
    const unsigned ldsw = (unsigned)wid * 1024u;
    const int aoff = lds_byte(wr * 64 + fr, fq * 8), boff = lds_byte(wc * 32 + fr, fq * 8);
#define PG8_SA(b, h) (((b) * 2 + (h)) * HTB)
#define PG8_SB(b, h) ((4 + (b) * 2 + (h)) * HTB)
#define PG8_STAGE(bufoff, gbase, voff) do { _Pragma("unroll") for (int _i = 0; _i < 2; ++_i) { unsigned _vo = (voff)[_i]; asm volatile("" : "+v"(_vo)); \
        __builtin_amdgcn_global_load_lds((const unsigned*)((const char*)(gbase) + _vo), (LAS unsigned*)(lds + (bufoff) + ldsw + _i * 8192), 16, 0, 0); } } while (0)
#define PG8_LDA(dst, b, h) do { _Pragma("unroll") for (int m = 0; m < 4; ++m) _Pragma("unroll") for (int k = 0; k < 2; ++k) dst[m][k] = *(const LAS bf16x8*)(lds + PG8_SA(b, h) + aoff + m * 2048 + k * 1024); } while (0)
#define PG8_LDB(dst, b, h) do { _Pragma("unroll") for (int n = 0; n < 2; ++n) _Pragma("unroll") for (int k = 0; k < 2; ++k) dst[n][k] = *(const LAS bf16x8*)(lds + PG8_SB(b, h) + boff + n * 2048 + k * 1024); } while (0)
#define PG8_MMA(ai, bj, At, Bt) do { __builtin_amdgcn_s_setprio(1); _Pragma("unroll") for (int m = 0; m < 4; ++m) _Pragma("unroll") for (int n = 0; n < 2; ++n) _Pragma("unroll") for (int k = 0; k < 2; ++k) \
        acc[ai][bj][m][n] = __builtin_amdgcn_mfma_f32_16x16x32_bf16(Bt[n][k], At[m][k], acc[ai][bj][m][n], 0, 0, 0); __builtin_amdgcn_s_setprio(0); } while (0)
#define PG8_WAIT_V(n) asm volatile("s_waitcnt vmcnt(" #n ")" ::: "memory")
#define PG8_WAIT_L(n) asm volatile("s_waitcnt lgkmcnt(" #n ")" ::: "memory")
#define PG8_BAR __builtin_amdgcn_s_barrier()
#define PG8_SCHED __builtin_amdgcn_sched_barrier(0)
    Unit cur, nxt; int ui = 0;
    if (!S.next(0, cur)) return;
    f32x4 acc[2][2][4][2];
#pragma unroll
    for (int a = 0; a < 2; ++a)
#pragma unroll
        for (int b = 0; b < 2; ++b)
#pragma unroll
            for (int m = 0; m < 4; ++m)
#pragma unroll
                for (int n = 0; n < 2; ++n) acc[a][b][m][n] = (f32x4){0.f, 0.f, 0.f, 0.f};
    bf16x8 At[4][2], B0[2][2], B1[2][2];
    const char* cA = (const char*)g.A + (size_t)cur.pm * tstepA; const char* cB = (const char*)g.Bt + (size_t)cur.pn * tstepB;
    PG8_SCHED; PG8_STAGE(PG8_SB(0, 0), cB, voffB); PG8_SCHED; PG8_STAGE(PG8_SB(0, 1), cB + hstepB, voffB); PG8_SCHED; PG8_STAGE(PG8_SA(0, 0), cA, voffA); PG8_SCHED; PG8_STAGE(PG8_SA(0, 1), cA + hstepA, voffA); PG8_SCHED;
    if (wr == 1) PG8_BAR;
    PG8_WAIT_V(2); PG8_BAR; PG8_SCHED;
    PG8_STAGE(PG8_SB(1, 0), cB + kstep, voffB); PG8_SCHED; PG8_STAGE(PG8_SA(1, 0), cA + kstep, voffA); PG8_SCHED; PG8_STAGE(PG8_SB(1, 1), cB + hstepB + kstep, voffB); PG8_SCHED;
    PG8_WAIT_V(6); PG8_BAR; PG8_SCHED;
    for (;;) {
        const bool has_next = S.next(ui + 1, nxt);
        const char* nA = has_next ? (const char*)g.A + (size_t)nxt.pm * tstepA : cA; const char* nB = has_next ? (const char*)g.Bt + (size_t)nxt.pn * tstepB : cB;
#define PG8_KLOOP(T0, T1) for (int t = (T0); t < (T1); t += 2) { \
            const bool last = (t == nt - 2); \
            const char* a1 = cA + (size_t)(t + 1) * kstep; \
            const char* a2 = last ? nA : cA + (size_t)(t + 2) * kstep; const char* b2 = last ? nB : cB + (size_t)(t + 2) * kstep; \
            const char* a3 = a2 + kstep; const char* b3 = b2 + kstep; \
            PG8_LDB(B0, 0, 0); PG8_LDB(B1, 0, 1); PG8_SCHED; PG8_LDA(At, 0, 0); PG8_STAGE(PG8_SA(1, 1), a1 + hstepA, voffA); \
            PG8_WAIT_V(8); PG8_WAIT_L(0); PG8_BAR; PG8_MMA(0, 0, At, B0); PG8_MMA(0, 1, At, B1); PG8_BAR; PG8_SCHED; \
            PG8_LDA(At, 0, 1); PG8_STAGE(PG8_SB(0, 0), b2, voffB); PG8_STAGE(PG8_SB(0, 1), b2 + hstepB, voffB); PG8_STAGE(PG8_SA(0, 0), a2, voffA); \
            PG8_WAIT_V(8); PG8_WAIT_L(0); PG8_BAR; PG8_MMA(1, 0, At, B0); PG8_MMA(1, 1, At, B1); PG8_BAR; PG8_SCHED; \
            PG8_LDB(B0, 1, 0); PG8_LDB(B1, 1, 1); PG8_SCHED; PG8_LDA(At, 1, 0); PG8_STAGE(PG8_SA(0, 1), a2 + hstepA, voffA); \
            PG8_WAIT_V(8); PG8_WAIT_L(0); PG8_BAR; PG8_MMA(0, 0, At, B0); PG8_MMA(0, 1, At, B1); PG8_BAR; PG8_SCHED; \
            PG8_LDA(At, 1, 1); PG8_STAGE(PG8_SB(1, 0), b3, voffB); PG8_STAGE(PG8_SB(1, 1), b3 + hstepB, voffB); PG8_STAGE(PG8_SA(1, 0), a3, voffA); \
            PG8_WAIT_V(8); PG8_WAIT_L(0); PG8_BAR; PG8_MMA(1, 0, At, B0); PG8_MMA(1, 1, At, B1); PG8_BAR; PG8_SCHED; \
        }
        if constexpr (Epi::FLUSH) { PG8_KLOOP(0, Epi::F1) E.flush(acc, cur, 0, wr, wc, fr, fq); PG8_SCHED; PG8_KLOOP(Epi::F1, Epi::F2) E.flush(acc, cur, 1, wr, wc, fr, fq); PG8_SCHED; PG8_KLOOP(Epi::F2, nt) }
        else { PG8_KLOOP(0, nt) }
#undef PG8_KLOOP
        if constexpr (ALIGN_EPI) { if (wr == 0) PG8_BAR; }
        E(acc, cur, wr, wc, fr, fq);
        if (!has_next) break;
#pragma unroll
        for (int a = 0; a < 2; ++a)
#pragma unroll
            for (int b = 0; b < 2; ++b)
#pragma unroll
                for (int m = 0; m < 4; ++m)
#pragma unroll
                    for (int n = 0; n < 2; ++n) acc[a][b][m][n] = (f32x4){0.f, 0.f, 0.f, 0.f};
        cur = nxt; cA = nA; cB = nB; ++ui;
        if constexpr (ALIGN_EPI) { if (wr == 1) PG8_BAR; }
    }
    PG8_WAIT_V(0);
    if constexpr (!ALIGN_EPI) { if (wr == 0) PG8_BAR; }
    PG8_BAR;
#undef PG8_SA
#undef PG8_SB
#undef PG8_STAGE
#undef PG8_LDA
#undef PG8_LDB
#undef PG8_MMA
#undef PG8_WAIT_V
#undef PG8_WAIT_L
#undef PG8_BAR
#undef PG8_SCHED
}

__device__ __forceinline__ u32x4 pack8(const f32x4 v0, const f32x4 v1) { u32x4 w; w.x = pk2(v0[0], v0[1]); w.y = pk2(v0[2], v0[3]); w.z = pk2(v1[0], v1[1]); w.w = pk2(v1[2], v1[3]); return w; }

struct EpiBf16 {
    static constexpr bool PERM = true, FLUSH = false;
    bf16_t* O; int ldc;
    __device__ __forceinline__ void operator()(const f32x4 (&acc)[2][2][4][2], const Unit& u, int wr, int wc, int fr, int fq) const {
        const int row0 = u.pm * BM + wr * 64 + fr, col0 = u.pn * BM + wc * 32 + 8 * fq;
#pragma unroll
        for (int ai = 0; ai < 2; ++ai)
#pragma unroll
            for (int m = 0; m < 4; ++m) { bf16_t* rowp = O + (size_t)(row0 + ai * HALF + m * 16) * ldc + col0;
#pragma unroll
                for (int bj = 0; bj < 2; ++bj) *(u32x4*)(rowp + bj * HALF) = pack8(acc[ai][bj][m][0], acc[ai][bj][m][1]); }
    }
};

struct EpiSwiglu {
    static constexpr bool PERM = true, FLUSH = false;
    bf16_t* O;
    __device__ __forceinline__ void operator()(const f32x4 (&acc)[2][2][4][2], const Unit& u, int wr, int wc, int fr, int fq) const {
        const int row0 = u.pm * BM + wr * 64 + fr, col0 = u.pn * HALF + wc * 32 + 8 * fq;
#pragma unroll
        for (int ai = 0; ai < 2; ++ai)
#pragma unroll
            for (int m = 0; m < 4; ++m) { bf16_t* rowp = O + (size_t)(row0 + ai * HALF + m * 16) * FF + col0;
                f32x4 v0, v1;
#pragma unroll
                for (int i = 0; i < 4; ++i) { const float g0 = acc[ai][0][m][0][i], g1 = acc[ai][0][m][1][i];
                    v0[i] = g0 * sigm(g0) * acc[ai][1][m][0][i]; v1[i] = g1 * sigm(g1) * acc[ai][1][m][1][i]; }
                *(u32x4*)rowp = pack8(v0, v1); }
    }
};

struct EpiGated {
    static constexpr bool PERM = true, FLUSH = true;
    static constexpr int F1 = 8, F2 = 12;
    const bf16_t* G; bf16_t* O;
    __device__ __forceinline__ void flush(f32x4 (&acc)[2][2][4][2], const Unit& u, int which, int wr, int wc, int fr, int fq) const {
        int row0 = u.pm * BM + wr * 64 + fr; asm volatile("" : "+v"(row0));
        const int col0 = u.pn * BM + wc * 32 + 8 * fq;
        const bf16_t* gbase = G + (size_t)row0 * GW + which * DM + col0; asm volatile("" : "+v"(gbase));
        u32x4 gn[2][2], gd[2][2];
#pragma unroll
        for (int bj = 0; bj < 2; ++bj) { const bf16_t* gp = gbase + bj * HALF; gn[0][bj] = *(const u32x4*)gp; gd[0][bj] = *(const u32x4*)(gp + DM); }
#pragma unroll
        for (int st = 0; st < 8; ++st) {
            const int ai = st >> 2, m = st & 3, cur = st & 1, nx = cur ^ 1;
            if (st < 7) { const int ai2 = (st + 1) >> 2, m2 = (st + 1) & 3;
#pragma unroll
                for (int bj = 0; bj < 2; ++bj) { const bf16_t* gp = gbase + (size_t)(ai2 * HALF + m2 * 16) * GW + bj * HALF; gn[nx][bj] = *(const u32x4*)gp; gd[nx][bj] = *(const u32x4*)(gp + DM); } }
#pragma unroll
            for (int bj = 0; bj < 2; ++bj) { const u32x4 a = gn[cur][bj], d = gd[cur][bj];
                float num[8] = {bflo(a.x), bfhi(a.x), bflo(a.y), bfhi(a.y), bflo(a.z), bfhi(a.z), bflo(a.w), bfhi(a.w)};
                float den[8] = {bflo(d.x), bfhi(d.x), bflo(d.y), bfhi(d.y), bflo(d.z), bfhi(d.z), bflo(d.w), bfhi(d.w)};
#pragma unroll
                for (int i = 0; i < 4; ++i) { const float n0 = which ? fmaxf(num[i], 1e-30f) : num[i], n1 = which ? fmaxf(num[4 + i], 1e-30f) : num[4 + i];
                    acc[ai][bj][m][0][i] *= n0 * __builtin_amdgcn_rcpf(fmaxf(den[i], 1e-30f)); acc[ai][bj][m][1][i] *= n1 * __builtin_amdgcn_rcpf(fmaxf(den[4 + i], 1e-30f)); } }
            __builtin_amdgcn_sched_barrier(0);
        }
    }
    __device__ __forceinline__ void operator()(const f32x4 (&acc)[2][2][4][2], const Unit& u, int wr, int wc, int fr, int fq) const {
        const int row0 = u.pm * BM + wr * 64 + fr, col0 = u.pn * BM + wc * 32 + 8 * fq;
#pragma unroll
        for (int ai = 0; ai < 2; ++ai)
#pragma unroll
            for (int m = 0; m < 4; ++m) { const size_t row = (size_t)(row0 + ai * HALF + m * 16);
#pragma unroll
                for (int bj = 0; bj < 2; ++bj) { const int col = col0 + bj * HALF;
                    const u32x4 gw = *(const u32x4*)(G + row * GW + 2 * DM + col);
                    f32x4 v0 = acc[ai][bj][m][0], v1 = acc[ai][bj][m][1];
                    v0[0] *= fmaxf(bflo(gw.x), 1e-30f); v0[1] *= fmaxf(bfhi(gw.x), 1e-30f); v0[2] *= fmaxf(bflo(gw.y), 1e-30f); v0[3] *= fmaxf(bfhi(gw.y), 1e-30f);
                    v1[0] *= fmaxf(bflo(gw.z), 1e-30f); v1[1] *= fmaxf(bfhi(gw.z), 1e-30f); v1[2] *= fmaxf(bflo(gw.w), 1e-30f); v1[3] *= fmaxf(bfhi(gw.w), 1e-30f);
                    *(u32x4*)(O + row * DM + col) = pack8(v0, v1); } }
    }
};

struct EpiIn {
    static constexpr bool PERM = true, FLUSH = false;
    bf16_t* Z1; bf16_t* G; const float* bgate; float* okwin; float* ovwin; float* okrow; float* ovrow; float* stats;
    __device__ __forceinline__ void operator()(const f32x4 (&acc)[2][2][4][2], const Unit& u, int wr, int wc, int fr, int fq) const {
        const int pn = u.pn, row0 = u.pm * BM + wr * 64 + fr, ct = wc * 32 + 8 * fq;
        if (pn < 15) {
            const bool gel = pn < 4; const bool kv = (pn == 7) || (pn == 8); const bool st = (pn == 2) || (pn == 3);
            long zb; int zp, zc; const long kvoff = ((long)WS_R2 - (long)WS_Z1) / 2;
            if (pn < 2) { zb = (long)ZB_U; zp = 512; zc = pn * 256; } else if (pn < 4) { zb = (long)ZB_GV; zp = 512; zc = (pn - 2) * 256; } else if (pn < 7) { zb = (long)ZB_Q; zp = 768; zc = (pn - 4) * 256; }
            else if (pn == 7) { zb = kvoff; zp = KVP; zc = 0; } else if (pn == 8) { zb = kvoff; zp = KVP; zc = 256; } else if (pn < 11) { zb = (long)ZB_CX; zp = 512; zc = (pn - 9) * 256; }
            else if (pn < 13) { zb = (long)ZB_CB; zp = 512; zc = (pn - 11) * 256; } else { zb = (long)ZB_CC; zp = 512; zc = (pn - 13) * 256; }
#pragma unroll
            for (int ai = 0; ai < 2; ++ai)
#pragma unroll
                for (int m = 0; m < 4; ++m) { const int row = row0 + ai * HALF + m * 16; bf16_t* rowp = Z1 + (zb + (long)row * zp + zc + ct);
                    float* dst = nullptr;
                    if (kv) { if (row < MPR) { const int s = row & (SEQ - 1); if (s >= SEQ - 2048) dst = (pn == 7 ? okwin : ovwin) + (size_t)((row >> 13) * 2048 + (s - (SEQ - 2048))) * 256; }
                              else if (row < MR) dst = (pn == 7 ? okrow : ovrow) + (size_t)(row - MPR) * 256; }
                    float ssum = 0.f, qsum = 0.f;
#pragma unroll
                    for (int bj = 0; bj < 2; ++bj) { f32x4 v0 = acc[ai][bj][m][0], v1 = acc[ai][bj][m][1];
                        if (gel) {
#pragma unroll
                            for (int i = 0; i < 4; ++i) { v0[i] = gelu_t(v0[i]); v1[i] = gelu_t(v1[i]); } }
                        if (st) {
#pragma unroll
                            for (int i = 0; i < 4; ++i) { ssum += v0[i] + v1[i]; qsum += v0[i] * v0[i] + v1[i] * v1[i]; } }
                        *(u32x4*)(rowp + bj * HALF) = pack8(v0, v1);
                        if (dst) { *(f32x4*)(dst + bj * HALF + ct) = v0; *(f32x4*)(dst + bj * HALF + ct + 4) = v1; } }
                    if (st) { ssum += __shfl_xor(ssum, 16); ssum += __shfl_xor(ssum, 32); qsum += __shfl_xor(qsum, 16); qsum += __shfl_xor(qsum, 32);
                        if (fq == 0 && row < MR) { atomicAdd(stats + (size_t)row * 2, ssum); atomicAdd(stats + (size_t)row * 2 + 1, qsum); } } }
        } else {
            const int cb = (pn - 15) * BM + ct;
#pragma unroll
            for (int bj = 0; bj < 2; ++bj) { const f32x4 b0 = *(const f32x4*)(bgate + cb + bj * HALF), b1 = *(const f32x4*)(bgate + cb + bj * HALF + 4);
#pragma unroll
                for (int ai = 0; ai < 2; ++ai)
#pragma unroll
                    for (int m = 0; m < 4; ++m) { const int row = row0 + ai * HALF + m * 16; f32x4 v0 = acc[ai][bj][m][0] + b0, v1 = acc[ai][bj][m][1] + b1;
#pragma unroll
                        for (int i = 0; i < 4; ++i) { v0[i] = sigm(v0[i]); v1[i] = sigm(v1[i]); }
                        *(u32x4*)(G + (size_t)row * GW + cb + bj * HALF) = pack8(v0, v1); } }
        }
    }
};
}

struct Params { const float* in[24]; float* out; unsigned char* ws; int ph_lo, ph_hi; };

__device__ __forceinline__ void transpose_item(const float* W, int N, int k0, int n0, bf16_t* WT, int ldt, int dst_row0, int dst_col0, LAS float* scr, int lane) {
#pragma unroll 8
    for (int i = 0; i < 32; ++i) { const int kk = 2 * i + (lane >> 5); scr[kk * 33 + (lane & 31)] = W[(size_t)(k0 + kk) * N + n0 + (lane & 31)]; }
    LDS_WAIT(); asm volatile("" ::: "memory");
    const int c = lane & 7;
#pragma unroll
    for (int j = 0; j < 4; ++j) { const int n = (lane >> 3) + 8 * j; const LAS float* s = scr + (8 * c) * 33 + n;
        u32x4 o; o.x = pk2(s[0 * 33], s[1 * 33]); o.y = pk2(s[2 * 33], s[3 * 33]); o.z = pk2(s[4 * 33], s[5 * 33]); o.w = pk2(s[6 * 33], s[7 * 33]);
        *(u32x4*)(WT + (size_t)(dst_row0 + n) * ldt + dst_col0 + k0 + 8 * c) = o; }
    LDS_WAIT(); asm volatile("" ::: "memory");
}

__device__ __forceinline__ void rms_row_to_bf16(const float* xrow, const float* gain, bf16_t* orow, int lane) {
    f32x4 v[4]; float s = 0.f;
#pragma unroll
    for (int j = 0; j < 4; ++j) { v[j] = *(const f32x4*)(xrow + 4 * lane + 256 * j); s += (v[j].x * v[j].x + v[j].y * v[j].y) + (v[j].z * v[j].z + v[j].w * v[j].w); }
    const float r = 1.f / sqrtf(wave_sum(s) * (1.f / DM) + EPS);
#pragma unroll
    for (int j = 0; j < 4; ++j) { const f32x4 gg = *(const f32x4*)(gain + 4 * lane + 256 * j);
        u32x2 o; o.x = pk2(v[j].x * r * gg.x, v[j].y * r * gg.y); o.y = pk2(v[j].z * r * gg.z, v[j].w * r * gg.w);
        *(u32x2*)(orow + 4 * lane + 256 * j) = o; }
}

constexpr int CV_I_IN = 16 * 216, CV_I_BA = 8 * 32, CV_I_BB = 4 * 32, CV_I_BC = 8 * 32, CV_I_O = 16 * 32, CV_I_G = 16 * 88, CV_I_U = 16 * 88, CV_I_D = 44 * 32;
constexpr int CV_SPLIT = 2304;
constexpr int CV_PER_LAYER = CV_I_IN + CV_I_BA + CV_I_BB + CV_I_BC + CV_I_O + CV_I_G + CV_I_U + CV_I_D;
__device__ __forceinline__ void convert_items(const Params& P, LAS unsigned char* lds, int l, int it0, int stride, int it_end = CV_PER_LAYER) {
    const int tid = opaque_tid(), lane = tid & 63, wave = tid >> 6;
    LAS float* scr = (LAS float*)(lds + wave * 16384);
    unsigned char* wl = P.ws + WS_W + (size_t)l * W_LAYER;
    for (int it = it0; it < it_end; it += stride) {
        int r = it;
        if (r < CV_I_IN) { const int kb = r / 216, nb = r % 216; transpose_item(P.in[9] + (size_t)l * DM * INW, INW, 64 * kb, 32 * nb, (bf16_t*)(wl + WO_IN), DM, 32 * nb, 0, scr, lane); continue; } r -= CV_I_IN;
        if (r < CV_I_BA) { const int kb = r / 32, nb = r % 32; transpose_item(P.in[16] + (size_t)l * 512 * DM, DM, 64 * kb, 32 * nb, (bf16_t*)(wl + WO_BR), MIXW, 32 * nb, 0, scr, lane); continue; } r -= CV_I_BA;
        if (r < CV_I_BB) { const int kb = r / 32, nb = r % 32; transpose_item(P.in[17] + (size_t)l * 256 * DM, DM, 64 * kb, 32 * nb, (bf16_t*)(wl + WO_BR), MIXW, 32 * nb, 512, scr, lane); continue; } r -= CV_I_BB;
        if (r < CV_I_BC) { const int kb = r / 32, nb = r % 32; transpose_item(P.in[18] + (size_t)l * 512 * DM, DM, 64 * kb, 32 * nb, (bf16_t*)(wl + WO_BR), MIXW, 32 * nb, 768, scr, lane); continue; } r -= CV_I_BC;
        if (r < CV_I_O) { const int kb = r / 32, nb = r % 32; transpose_item(P.in[20] + (size_t)l * DM * DM, DM, 64 * kb, 32 * nb, (bf16_t*)(wl + WO_O), DM, 32 * nb, 0, scr, lane); continue; } r -= CV_I_O;
        if (r < CV_I_G) { const int kb = r / 88, nb = r % 88; const int n0 = 32 * nb; transpose_item(P.in[21] + (size_t)l * DM * FF, FF, 64 * kb, n0, (bf16_t*)(wl + WO_GU), DM, (n0 >> 7) * 256 + (n0 & 127), 0, scr, lane); continue; } r -= CV_I_G;
        if (r < CV_I_U) { const int kb = r / 88, nb = r % 88; const int n0 = 32 * nb; transpose_item(P.in[22] + (size_t)l * DM * FF, FF, 64 * kb, n0, (bf16_t*)(wl + WO_GU), DM, (n0 >> 7) * 256 + (n0 & 127) + 128, 0, scr, lane); continue; } r -= CV_I_U;
        { const int kb = r / 32, nb = r % 32; transpose_item(P.in[23] + (size_t)l * FF * DM, DM, 64 * kb, 32 * nb, (bf16_t*)(wl + WO_D), FF, 32 * nb, 0, scr, lane); }
    }
}
__device__ __forceinline__ int up_full_blocks(int G) { const int nwg = (MPAD / 256) * (2 * FF / 256); const int rounds = (nwg + G - 1) / G; return nwg - (rounds - 1) * G; }
__device__ __forceinline__ bool defer_layer1(int G) { const int nf = up_full_blocks(G); return (G - nf) >= 64; }
__device__ __forceinline__ void phase_prologue(const Params& P, LAS unsigned char* lds) {
    const int tid = opaque_tid(), lane = tid & 63, wave = tid >> 6;
    const int gw = opaque_bid() * 8 + wave, NGW = gridDim.x * 8;
    convert_items(P, lds, 0, gw, NGW);
    if (!defer_layer1(gridDim.x)) convert_items(P, lds, 1, gw, NGW);
    bf16_t* H = (bf16_t*)(P.ws + WS_R1);
    for (int m = gw; m < MR; m += NGW) {
        const float* xr = m < MPR ? P.in[0] + (size_t)m * DM : P.in[1] + (size_t)(m - MPR) * DM;
        rms_row_to_bf16(xr, P.in[5], H + (size_t)m * DM, lane);
    }
}

__device__ __forceinline__ float alibi_slope(int i) { return exp2f(-8.0f * (float)(i + 1) / 12.0f); }

constexpr int KS_PITCH = 72, VT_PITCH = 264;
constexpr int ATT_VT = 256 * KS_PITCH * 2, ATT_BUF = ATT_VT + 64 * VT_PITCH * 2;
struct AttnPre { u32x4 kk[4], vv[4]; bf16x8 qf[2]; };
__device__ __forceinline__ void attn_decode(int u, int& b, int& g, int& tile, int& h) { h = u & 3; tile = (u >> 2) & 63; const int bg = u >> 8; b = bg / 3; g = bg - 3 * b; }
__device__ __forceinline__ void attn_prefetch(const Params& P, int u, int tid, AttnPre& R) {
    int b, g, tile, h; attn_decode(u, b, g, tile, h);
    const int lane = tid & 63, w = tid >> 6, fr = lane & 15, fq = lane >> 4;
    const int sh = 2 * g, dil = 1 << sh, r = tile & (dil - 1), n = tile >> sh;
    const bf16_t* Z1 = (const bf16_t*)(P.ws + WS_Z1);
#pragma unroll
    for (int i = 0; i < 4; ++i) {
        const int c = tid + 512 * i, key = c >> 3, part = c & 7;
        const int jp = 128 * (n - 1) + key;
        R.kk[i] = (u32x4){0u, 0u, 0u, 0u}; R.vv[i] = (u32x4){0u, 0u, 0u, 0u};
        if (jp >= 0) { const bf16_t* rp = (const bf16_t*)(P.ws + WS_R2) + (size_t)(b * SEQ + jp * dil + r) * KVP + h * 64 + 8 * part;
            R.kk[i] = *(const u32x4*)rp; R.vv[i] = *(const u32x4*)(rp + 256); }
    }
    const int q = 16 * w + fr;
    const size_t qrow = (size_t)(b * SEQ + (128 * n + q) * dil + r);
    const bf16_t* qp = Z1 + ZB_Q + qrow * ZP_Q + (g * 4 + h) * 64 + 8 * fq; R.qf[0] = *(const bf16x8*)qp; R.qf[1] = *(const bf16x8*)(qp + 32);
}
__device__ __forceinline__ void attn_stage(LAS unsigned char* buf, int tid, const AttnPre& R) {
    LAS bf16_t* Ks = (LAS bf16_t*)buf; LAS bf16_t* Vt = (LAS bf16_t*)(buf + ATT_VT);
#pragma unroll
    for (int i = 0; i < 4; ++i) {
        const int c = tid + 512 * i, key = c >> 3, part = c & 7;
        *(LAS u32x4*)(Ks + key * KS_PITCH + 8 * part) = R.kk[i];
        LAS bf16_t* vp = Vt + (8 * part) * VT_PITCH + (key ^ (part << 3));
        const u32x4 vv = R.vv[i];
        vp[0 * VT_PITCH] = (bf16_t)(vv.x & 0xffffu); vp[1 * VT_PITCH] = (bf16_t)(vv.x >> 16);
        vp[2 * VT_PITCH] = (bf16_t)(vv.y & 0xffffu); vp[3 * VT_PITCH] = (bf16_t)(vv.y >> 16);
        vp[4 * VT_PITCH] = (bf16_t)(vv.z & 0xffffu); vp[5 * VT_PITCH] = (bf16_t)(vv.z >> 16);
        vp[6 * VT_PITCH] = (bf16_t)(vv.w & 0xffffu); vp[7 * VT_PITCH] = (bf16_t)(vv.w >> 16);
    }
}
__device__ __forceinline__ void attn_compute(const Params& P, LAS unsigned char* buf, int u, int tid, const bf16x8 (&qf)[2]) {
    int b, g, tile, h; attn_decode(u, b, g, tile, h);
    const int lane = tid & 63, w = tid >> 6, fr = lane & 15, fq = lane >> 4;
    const int sh = 2 * g, dil = 1 << sh, r = tile & (dil - 1), n = tile >> sh;
    const LAS bf16_t* Ks = (const LAS bf16_t*)buf; const LAS bf16_t* Vt = (const LAS bf16_t*)(buf + ATT_VT);
    const int q = 16 * w + fr;
    const size_t qrow = (size_t)(b * SEQ + (128 * n + q) * dil + r);
    const float sl = alibi_slope(g * 4 + h) * (float)dil;
    f32x4 sc[9];
    float mx = -INFINITY;
#pragma unroll
    for (int kb = 0; kb < 9; ++kb) {
        const LAS bf16_t* kp = Ks + (16 * (w + kb) + fr) * KS_PITCH + 8 * fq;
        f32x4 a = (f32x4){0.f, 0.f, 0.f, 0.f};
        a = __builtin_amdgcn_mfma_f32_16x16x32_bf16(*(const LAS bf16x8*)kp, qf[0], a, 0, 0, 0);
        a = __builtin_amdgcn_mfma_f32_16x16x32_bf16(*(const LAS bf16x8*)(kp + 32), qf[1], a, 0, 0, 0);
#pragma unroll
        for (int i = 0; i < 4; ++i) {
            const int dist = fr + 128 - 16 * kb - 4 * fq - i;
            const int kidx = 16 * (w + kb) + 4 * fq + i;
            const bool valid = (dist >= 0) && (dist <= 128) && (n > 0 || kidx >= 128);
            const float sv = valid ? a[i] * 0.125f - sl * (float)dist : -INFINITY;
            a[i] = sv; mx = fmaxf(mx, sv);
        }
        sc[kb] = a;
    }
    mx = fmaxf(mx, __shfl_xor(mx, 16)); mx = fmaxf(mx, __shfl_xor(mx, 32));
    float den = 0.f;
    f32x4 o[4];
#pragma unroll
    for (int d = 0; d < 4; ++d) o[d] = (f32x4){0.f, 0.f, 0.f, 0.f};
#pragma unroll
    for (int kb = 0; kb < 9; ++kb) {
        f32x4 p;
#pragma unroll
        for (int i = 0; i < 4; ++i) { p[i] = __expf(sc[kb][i] - mx); den += p[i]; }
        u32x2 pw; pw.x = pk2(p[0], p[1]); pw.y = pk2(p[2], p[3]);
        const bf16x4 pf = __builtin_bit_cast(bf16x4, pw);
#pragma unroll
        for (int d = 0; d < 4; ++d) {
            const int vrow = 16 * d + fr;
            const bf16x4 vf = *(const LAS bf16x4*)(Vt + vrow * VT_PITCH + ((16 * (w + kb) + 4 * fq) ^ (((vrow >> 3) & 7) << 3)));
            o[d] = __builtin_amdgcn_mfma_f32_16x16x16bf16_1k(vf, pf, o[d], 0, 0, 0);
        }
    }
    den += __shfl_xor(den, 16); den += __shfl_xor(den, 32);
    const float rden = 1.f / den;
    bf16_t* og = (bf16_t*)(P.ws + WS_R3) + ((size_t)g * MPR + qrow) * 256 + h * 64 + 4 * fq;
#pragma unroll
    for (int d = 0; d < 4; ++d) { u32x2 ow; ow.x = pk2(o[d][0] * rden, o[d][1] * rden); ow.y = pk2(o[d][2] * rden, o[d][3] * rden); *(u32x2*)(og + 16 * d) = ow; }
    if (fq == 0) { float* lse = (float*)(P.ws + WS_R3 + R3_LSE); lse[((size_t)g * MPR + qrow) * 4 + h] = mx + __logf(den); }
}
__device__ __forceinline__ void attn_prompt_loop(const Params& P, LAS unsigned char* lds) {
    const int tid = opaque_tid(); const int G = gridDim.x;
    int u = opaque_bid();
    if (u >= 1536) return;
    AttnPre R; attn_prefetch(P, u, tid, R);
    int buf = 0;
    for (;;) {
        bf16x8 qc[2] = {R.qf[0], R.qf[1]};
        attn_stage(lds + buf * ATT_BUF, tid, R);
        const int un = u + G;
        if (un < 1536) attn_prefetch(P, un, tid, R);
        __syncthreads();
        attn_compute(P, lds + buf * ATT_BUF, u, tid, qc);
        if (un >= 1536) break;
        u = un; buf ^= 1;
    }
    __syncthreads();
}

constexpr int SPN = 24;
constexpr size_t R3_SPO = 25 * MiB, R3_SPML = R3_SPO + (size_t)128 * SPN * 256 * 4;
__device__ __forceinline__ void attn_sample_wave(const Params& P, int l, int wu) {
    const int lane = opaque_tid() & 63, h = lane >> 4, dq = (lane & 15) * 4;
    const int qt = wu & 7, g = (wu >> 3) % 3, rt = wu / 24, db = rt >> 2, t = rt & 3;
    const bf16_t* Z1 = (const bf16_t*)(P.ws + WS_Z1);
    const size_t row = (size_t)(MPR + rt);
    const float* ck = P.in[2] + ((size_t)(l * 32 + db) * 2048) * 256 + h * 64 + dq;
    const float* cv = P.in[3] + ((size_t)(l * 32 + db) * 2048) * 256 + h * 64 + dq;
    const float* nk = P.out + O_KROW + ((size_t)(l * 128 + db * 4)) * 256 + h * 64 + dq;
    const float* nv = P.out + O_VROW + ((size_t)(l * 128 + db * 4)) * 256 + h * 64 + dq;
    const int dil = 1 << (2 * g);
    const float sl = alibi_slope(g * 4 + h) * (float)dil;
    f32x4 q4;
    { const u32x2 qw = *(const u32x2*)(Z1 + ZB_Q + row * ZP_Q + (g * 4 + h) * 64 + dq); q4 = (f32x4){bflo(qw.x), bfhi(qw.x), bflo(qw.y), bfhi(qw.y)} * 0.125f; }
    const int j0 = 17 * qt;
    f32x4 kr[17], vr[17];
#pragma unroll
    for (int i = 0; i < 17; ++i) { const int j = j0 + i; const int jj = j < 129 ? j : 128; const int idx = 2048 + t - dil * jj;
        kr[i] = *(const f32x4*)(idx < 2048 ? ck + (size_t)idx * 256 : nk + (size_t)(idx - 2048) * 256);
        vr[i] = *(const f32x4*)(idx < 2048 ? cv + (size_t)idx * 256 : nv + (size_t)(idx - 2048) * 256); }
    float sv[17]; float m = -INFINITY;
#pragma unroll
    for (int i = 0; i < 17; ++i) { const int j = j0 + i;
        float d = (q4.x * kr[i].x + q4.y * kr[i].y) + (q4.z * kr[i].z + q4.w * kr[i].w);
        d += __shfl_xor(d, 1); d += __shfl_xor(d, 2); d += __shfl_xor(d, 4); d += __shfl_xor(d, 8);
        sv[i] = j < 129 ? d - sl * (float)j : -INFINITY; m = fmaxf(m, sv[i]); }
    f32x4 o4 = (f32x4){0.f, 0.f, 0.f, 0.f}; float lsum = 0.f;
#pragma unroll
    for (int i = 0; i < 17; ++i) { const float p = __expf(sv[i] - m); lsum += p; o4 += vr[i] * p; }
    float* spo = (float*)(P.ws + WS_R3 + R3_SPO) + ((size_t)rt * SPN + g * 8 + qt) * 256 + h * 64 + dq;
    *(f32x4*)spo = o4;
    if ((lane & 15) == 0) { float* ml = (float*)(P.ws + WS_R3 + R3_SPML) + (((size_t)rt * SPN + g * 8 + qt) * 4 + h) * 2; ml[0] = m; ml[1] = lsum; }
}

constexpr int GP = 136;
constexpr int GPX = 184;
constexpr int GATE_WT = 0, GATE_RS = 128 * GP * 2, GATE_XT = GATE_RS + 512, GATE_XT_BYTES = 128 * GPX * 2;
struct GatePre { u32x4 xv[4]; f32x2 sq[4]; u32x2 uw[8]; };
__device__ __forceinline__ void gate_prefetch(const Params& P, int l, int u, int tid, GatePre& R) {
    const int chunk = u >> 2, g = u & 3; const int lane = tid & 63, w = tid >> 6, fr = lane & 15, fq = lane >> 4;
    const bf16_t* Z1 = (const bf16_t*)(P.ws + WS_Z1);
    const float* stats = (const float*)(P.ws + 65536) + (size_t)l * MR * 2;
    const size_t row0 = (size_t)chunk * 128;
#pragma unroll
    for (int i = 0; i < 4; ++i) { const int item = tid + 512 * i, ss = item >> 4, oc = item & 15;
        R.xv[i] = *(const u32x4*)(Z1 + ZB_GV + (row0 + ss) * ZP_GV + g * 128 + 8 * oc); R.sq[i] = *(const f32x2*)(stats + (row0 + ss) * 2); }
    const bf16_t* up = Z1 + ZB_U + (row0 + 16 * w + fr) * ZP_U + g * 128 + 4 * fq;
#pragma unroll
    for (int cb = 0; cb < 8; ++cb) R.uw[cb] = *(const u32x2*)(up + 16 * cb);
}
__device__ __forceinline__ void gate_stage_w(const Params& P, LAS unsigned char* lds, int l, int g, int tid) {
    LAS bf16_t* Wt = (LAS bf16_t*)(lds + GATE_WT); LAS float* rs = (LAS float*)(lds + GATE_RS);
    const float* Wsrc = P.in[12] + (size_t)(l * 4 + g) * 128 * 128;
    f32x4 wv[8];
#pragma unroll
    for (int i = 0; i < 8; ++i) wv[i] = *(const f32x4*)(Wsrc + (tid + 512 * i) * 4);
#pragma unroll
    for (int i = 0; i < 8; ++i) {
        const int e = (tid + 512 * i) * 4, tt = e >> 7, ss = e & 127;
        f32x4 x = wv[i]; x.x = ss <= tt ? x.x : 0.f; x.y = ss + 1 <= tt ? x.y : 0.f; x.z = ss + 2 <= tt ? x.z : 0.f; x.w = ss + 3 <= tt ? x.w : 0.f;
        u32x2 o; o.x = pk2(x.x, x.y); o.y = pk2(x.z, x.w);
        *(LAS u32x2*)(Wt + tt * GP + ss) = o;
        float ps = (x.x + x.y) + (x.z + x.w);
        ps += __shfl_xor(ps, 1); ps += __shfl_xor(ps, 2); ps += __shfl_xor(ps, 4); ps += __shfl_xor(ps, 8); ps += __shfl_xor(ps, 16);
        if ((tid & 31) == 0) rs[tt] = ps;
    }
}
__device__ __forceinline__ void gate_stage_x(LAS unsigned char* xbuf, int tid, const GatePre& R) {
    LAS bf16_t* VnT = (LAS bf16_t*)xbuf;
#pragma unroll
    for (int i = 0; i < 4; ++i) {
        const int item = tid + 512 * i, ss = item >> 4, oc = item & 15;
        const float mean = R.sq[i].x * (1.f / 512.f); const float var = fmaxf(R.sq[i].y * (1.f / 512.f) - mean * mean, 0.f); const float rstd = 1.f / sqrtf(var + EPS);
        const u32x4 x = R.xv[i];
        float v[8] = {bflo(x.x), bfhi(x.x), bflo(x.y), bfhi(x.y), bflo(x.z), bfhi(x.z), bflo(x.w), bfhi(x.w)};
        const int scol = ss + ((oc & 7) << 3);
#pragma unroll
        for (int e = 0; e < 8; ++e) VnT[(8 * oc + e) * GPX + scol] = (bf16_t)f2bf((v[e] - mean) * rstd);
    }
}
__device__ __forceinline__ void gate_compute(const Params& P, LAS unsigned char* lds, LAS unsigned char* xbuf, int l, int u, int tid, const u32x2 (&uw)[8]) {
    const int chunk = u >> 2, g = u & 3; const int lane = tid & 63, w = tid >> 6, fr = lane & 15, fq = lane >> 4;
    const LAS bf16_t* Wt = (const LAS bf16_t*)(lds + GATE_WT); const LAS float* rs = (const LAS float*)(lds + GATE_RS); const LAS bf16_t* VnT = (const LAS bf16_t*)xbuf;
    const int tt = 16 * w + fr;
    const float* lng = P.in[10] + l * 512 + g * 128 + 4 * fq; const float* lnb = P.in[11] + l * 512 + g * 128 + 4 * fq;
    f32x4 ga[8], be[8];
#pragma unroll
    for (int cb = 0; cb < 8; ++cb) { ga[cb] = *(const f32x4*)(lng + 16 * cb); be[cb] = *(const f32x4*)(lnb + 16 * cb); }
    const float bs = P.in[13][(size_t)(l * 4 + g) * 128 + tt];
    f32x4 acc[8];
#pragma unroll
    for (int cb = 0; cb < 8; ++cb) acc[cb] = (f32x4){0.f, 0.f, 0.f, 0.f};
    const LAS bf16_t* xlane = VnT + fr * GPX + 8 * fq + 8 * (fr >> 3);
#pragma unroll
    for (int ks = 0; ks < 4; ++ks) {
        const bf16x8 af = *(const LAS bf16x8*)(Wt + (16 * w + fr) * GP + 32 * ks + 8 * fq);
#pragma unroll
        for (int cb = 0; cb < 8; ++cb) {
            const bf16x8 bfv = *(const LAS bf16x8*)(xlane + (16 * cb * GPX + 16 * (cb & 3) + 32 * ks));
            acc[cb] = __builtin_amdgcn_mfma_f32_16x16x32_bf16(bfv, af, acc[cb], 0, 0, 0);
        }
    }
    const float rst = rs[tt];
    bf16_t* op = (bf16_t*)(P.ws + WS_R1) + ((size_t)chunk * 128 + tt) * MIXW + g * 128 + 4 * fq;
#pragma unroll
    for (int cb = 0; cb < 8; ++cb) {
        u32x2 ow; ow.x = pk2(bflo(uw[cb].x) * (ga[cb].x * acc[cb][0] + be[cb].x * rst + bs), bfhi(uw[cb].x) * (ga[cb].y * acc[cb][1] + be[cb].y * rst + bs));
        ow.y = pk2(bflo(uw[cb].y) * (ga[cb].z * acc[cb][2] + be[cb].z * rst + bs), bfhi(uw[cb].y) * (ga[cb].w * acc[cb][3] + be[cb].w * rst + bs));
        *(u32x2*)(op + 16 * cb) = ow;
    }
}
__device__ __forceinline__ void gate_prompt_loop(const Params& P, LAS unsigned char* lds, int l) {
    const int tid = opaque_tid(); const int G = gridDim.x;
    int u = opaque_bid();
    if (u >= 512) return;
    GatePre R; gate_prefetch(P, l, u, tid, R);
    int gcur = -1, buf = 0;
    for (;;) {
        if ((u & 3) != gcur) { if (gcur >= 0) __syncthreads(); gcur = u & 3; gate_stage_w(P, lds, l, gcur, tid); }
        u32x2 uc[8];
#pragma unroll
        for (int cb = 0; cb < 8; ++cb) uc[cb] = R.uw[cb];
        LAS unsigned char* xb = lds + GATE_XT + buf * GATE_XT_BYTES;
        gate_stage_x(xb, tid, R);
        const int un = u + G;
        if (un < 512) gate_prefetch(P, l, un, tid, R);
        __syncthreads();
        gate_compute(P, lds, xb, l, u, tid, uc);
        if (un >= 512) break;
        u = un; buf ^= 1;
    }
    __syncthreads();
}

__device__ __forceinline__ void sample_gc_unit(const Params& P, int l, int db) {
    const int tid = opaque_tid();
    const bf16_t* Z1 = (const bf16_t*)(P.ws + WS_Z1);
    const float* stats = (const float*)(P.ws + 65536) + (size_t)l * MR * 2;
    const size_t row0 = (size_t)(MPR + db * 4);
    const int c = tid, g = c >> 7;
    bf16_t* MIX = (bf16_t*)(P.ws + WS_R1);
    {
        const float lg = P.in[10][l * 512 + c], lb = P.in[11][l * 512 + c];
        float vn[4];
#pragma unroll
        for (int s = 0; s < 4; ++s) { const f32x2 sq = *(const f32x2*)(stats + (row0 + s) * 2);
            const float mean = sq.x * (1.f / 512.f); const float var = fmaxf(sq.y * (1.f / 512.f) - mean * mean, 0.f); const float rstd = 1.f / sqrtf(var + EPS);
            vn[s] = (bf1(Z1[ZB_GV + (row0 + s) * ZP_GV + c]) - mean) * rstd * lg + lb;
            P.out[O_AV + ((size_t)(l * 128 + db * 4 + s)) * 512 + c] = vn[s]; }
        const float* Wsrc = P.in[12] + (size_t)(l * 4 + g) * 128 * 128;
#pragma unroll
        for (int t = 0; t < 4; ++t) { float sa = P.in[13][(size_t)(l * 4 + g) * 128 + t];
#pragma unroll
            for (int s = 0; s < 4; ++s) if (s <= t) sa += Wsrc[t * 128 + s] * vn[s];
            MIX[(row0 + t) * MIXW + c] = (bf16_t)f2bf(bf1(Z1[ZB_U + (row0 + t) * ZP_U + c]) * sa); }
    }
    {
        float zp[6];
        zp[0] = P.in[4][((size_t)(l * 32 + db) * 2 + 0) * 512 + c]; zp[1] = P.in[4][((size_t)(l * 32 + db) * 2 + 1) * 512 + c];
#pragma unroll
        for (int t = 0; t < 4; ++t) zp[2 + t] = bf1(Z1[ZB_CC + (row0 + t) * ZP_CC + c]) * bf1(Z1[ZB_CX + (row0 + t) * ZP_CX + c]);
        const float w0 = P.in[14][(size_t)(l * 3 + 0) * 512 + c], w1 = P.in[14][(size_t)(l * 3 + 1) * 512 + c], w2 = P.in[14][(size_t)(l * 3 + 2) * 512 + c], cbias = P.in[15][l * 512 + c];
#pragma unroll
        for (int t = 0; t < 4; ++t) { const float conv = cbias + w0 * zp[t] + w1 * zp[t + 1] + w2 * zp[t + 2];
            MIX[(row0 + t) * MIXW + 768 + c] = (bf16_t)f2bf(bf1(Z1[ZB_CB + (row0 + t) * ZP_CB + c]) * conv); }
        P.out[O_CONVS + ((size_t)(l * 32 + db) * 2 + 0) * 512 + c] = zp[4];
        P.out[O_CONVS + ((size_t)(l * 32 + db) * 2 + 1) * 512 + c] = zp[5];
    }
}

__device__ __forceinline__ void conv_prompt_unit(const Params& P, int l, int rb) {
    const int tid = opaque_tid(), oc = tid & 63, rs = tid >> 6;
    const bf16_t* Z1 = (const bf16_t*)(P.ws + WS_Z1);
    bf16_t* MIX = (bf16_t*)(P.ws + WS_R1);
    const size_t row0 = (size_t)rb * 64 + rs * 8;
    const int s0 = (int)(row0 & (SEQ - 1)), bb = (int)(row0 >> 13);
    float w0[8], w1[8], w2[8], cbias[8], zm2[8], zm1[8];
    { const float* cw = P.in[14] + (size_t)l * 3 * 512 + 8 * oc; const float* cbp = P.in[15] + l * 512 + 8 * oc;
      const f32x4 a0 = *(const f32x4*)cw, a1 = *(const f32x4*)(cw + 4), b0 = *(const f32x4*)(cw + 512), b1 = *(const f32x4*)(cw + 516), c0 = *(const f32x4*)(cw + 1024), c1 = *(const f32x4*)(cw + 1028), d0 = *(const f32x4*)cbp, d1 = *(const f32x4*)(cbp + 4);
#pragma unroll
      for (int e = 0; e < 4; ++e) { w0[e] = a0[e]; w0[4 + e] = a1[e]; w1[e] = b0[e]; w1[4 + e] = b1[e]; w2[e] = c0[e]; w2[4 + e] = c1[e]; cbias[e] = d0[e]; cbias[4 + e] = d1[e]; } }
#pragma unroll
    for (int e = 0; e < 8; ++e) { zm2[e] = 0.f; zm1[e] = 0.f; }
    if (s0 >= 2) {
        const u32x4 a2 = *(const u32x4*)(Z1 + ZB_CC + (row0 - 2) * ZP_CC + 8 * oc), b2 = *(const u32x4*)(Z1 + ZB_CX + (row0 - 2) * ZP_CX + 8 * oc);
        const u32x4 a1 = *(const u32x4*)(Z1 + ZB_CC + (row0 - 1) * ZP_CC + 8 * oc), b1 = *(const u32x4*)(Z1 + ZB_CX + (row0 - 1) * ZP_CX + 8 * oc);
        zm2[0] = bflo(a2.x) * bflo(b2.x); zm2[1] = bfhi(a2.x) * bfhi(b2.x); zm2[2] = bflo(a2.y) * bflo(b2.y); zm2[3] = bfhi(a2.y) * bfhi(b2.y);
        zm2[4] = bflo(a2.z) * bflo(b2.z); zm2[5] = bfhi(a2.z) * bfhi(b2.z); zm2[6] = bflo(a2.w) * bflo(b2.w); zm2[7] = bfhi(a2.w) * bfhi(b2.w);
        zm1[0] = bflo(a1.x) * bflo(b1.x); zm1[1] = bfhi(a1.x) * bfhi(b1.x); zm1[2] = bflo(a1.y) * bflo(b1.y); zm1[3] = bfhi(a1.y) * bfhi(b1.y);
        zm1[4] = bflo(a1.z) * bflo(b1.z); zm1[5] = bfhi(a1.z) * bfhi(b1.z); zm1[6] = bflo(a1.w) * bflo(b1.w); zm1[7] = bfhi(a1.w) * bfhi(b1.w);
    }
#pragma unroll
    for (int i = 0; i < 8; ++i) {
        const size_t row = row0 + i;
        const u32x4 a = *(const u32x4*)(Z1 + ZB_CC + row * ZP_CC + 8 * oc), b = *(const u32x4*)(Z1 + ZB_CX + row * ZP_CX + 8 * oc), cbv = *(const u32x4*)(Z1 + ZB_CB + row * ZP_CB + 8 * oc);
        float z[8] = {bflo(a.x) * bflo(b.x), bfhi(a.x) * bfhi(b.x), bflo(a.y) * bflo(b.y), bfhi(a.y) * bfhi(b.y), bflo(a.z) * bflo(b.z), bfhi(a.z) * bfhi(b.z), bflo(a.w) * bflo(b.w), bfhi(a.w) * bfhi(b.w)};
        float cbf[8] = {bflo(cbv.x), bfhi(cbv.x), bflo(cbv.y), bfhi(cbv.y), bflo(cbv.z), bfhi(cbv.z), bflo(cbv.w), bfhi(cbv.w)};
        float oo[8];
#pragma unroll
        for (int e = 0; e < 8; ++e) { oo[e] = cbf[e] * (cbias[e] + w0[e] * zm2[e] + w1[e] * zm1[e] + w2[e] * z[e]); zm2[e] = zm1[e]; zm1[e] = z[e]; }
        u32x4 ow; ow.x = pk2(oo[0], oo[1]); ow.y = pk2(oo[2], oo[3]); ow.z = pk2(oo[4], oo[5]); ow.w = pk2(oo[6], oo[7]);
        *(u32x4*)(MIX + row * MIXW + 768 + 8 * oc) = ow;
        const int sp = s0 + i;
        if (sp >= SEQ - 2) { float* dst = P.out + O_CONVP + ((size_t)(l * 2 + bb) * 2 + (sp - (SEQ - 2))) * 512 + 8 * oc;
            *(f32x4*)dst = (f32x4){z[0], z[1], z[2], z[3]}; *(f32x4*)(dst + 4) = (f32x4){z[4], z[5], z[6], z[7]}; }
    }
}

__device__ __forceinline__ void phase_mixer(const Params& P, LAS unsigned char* lds, int l, int mask = 31) {
    const int bid = opaque_bid(), G = gridDim.x;
    if (mask & 1) { const int wv = __builtin_amdgcn_readfirstlane(opaque_tid() >> 6); const int wu0 = wv * G + bid; if (wu0 < 3072) attn_sample_wave(P, l, wu0); if (wu0 + 8 * G < 3072) attn_sample_wave(P, l, wu0 + 8 * G);
        if (G < 192) for (int wu = wu0 + 16 * G; wu < 3072; wu += G * 8) attn_sample_wave(P, l, wu); }
    const bool conv_first = (bid & 1) == 0;
    if (conv_first) { if (mask & 2) for (int u = bid; u < 32; u += G) sample_gc_unit(P, l, u);
                      if (mask & 16) for (int u = bid; u < 256; u += G) conv_prompt_unit(P, l, u); }
    if (mask & 4) gate_prompt_loop(P, lds, l);
    if (mask & 8) attn_prompt_loop(P, lds);
    if (!conv_first) { if (mask & 2) for (int u = bid; u < 32; u += G) sample_gc_unit(P, l, u);
                       if (mask & 16) for (int u = bid; u < 256; u += G) conv_prompt_unit(P, l, u); }
}

__device__ __forceinline__ void phase_combine(const Params& P) {
    const bf16_t* og = (const bf16_t*)(P.ws + WS_R3); const float* lse = (const float*)(P.ws + WS_R3 + R3_LSE);
    bf16_t* MIX = (bf16_t*)(P.ws + WS_R1);
    const int nth = gridDim.x * 512; const int gtid = opaque_bid() * 512 + opaque_tid();
    if (gtid < 128 * 64) {
        const int rt = gtid >> 6, h = (gtid >> 4) & 3, dq = (gtid & 15) * 4;
        const float* ml = (const float*)(P.ws + WS_R3 + R3_SPML) + (size_t)rt * SPN * 8 + h * 2;
        const float* spo = (const float*)(P.ws + WS_R3 + R3_SPO) + (size_t)rt * SPN * 256 + h * 64 + dq;
        float M = -INFINITY;
#pragma unroll
        for (int i = 0; i < SPN; ++i) M = fmaxf(M, ml[i * 8]);
        f32x4 acc = (f32x4){0.f, 0.f, 0.f, 0.f}; float L = 0.f;
#pragma unroll
        for (int i = 0; i < SPN; ++i) { const float f = __expf(ml[i * 8] - M); L += f * ml[i * 8 + 1]; acc += *(const f32x4*)(spo + i * 256) * f; }
        const float rl = 1.f / L;
        u32x2 ow; ow.x = pk2(acc.x * rl, acc.y * rl); ow.y = pk2(acc.z * rl, acc.w * rl);
        *(u32x2*)(MIX + (size_t)(MPR + rt) * MIXW + 512 + h * 64 + dq) = ow;
    }
    for (int idx = gtid; idx < MPR * 32; idx += nth) {
        const int part = idx & 7, h = (idx >> 3) & 3; const size_t row = (size_t)(idx >> 5);
        const float l0 = lse[(0 * (size_t)MPR + row) * 4 + h], l1 = lse[(1 * (size_t)MPR + row) * 4 + h], l2 = lse[(2 * (size_t)MPR + row) * 4 + h];
        const float m = fmaxf(l0, fmaxf(l1, l2));
        float w0 = __expf(l0 - m), w1 = __expf(l1 - m), w2 = __expf(l2 - m); const float rs = 1.f / (w0 + w1 + w2); w0 *= rs; w1 *= rs; w2 *= rs;
        const u32x4 a = *(const u32x4*)(og + (0 * (size_t)MPR + row) * 256 + h * 64 + 8 * part);
        const u32x4 b = *(const u32x4*)(og + (1 * (size_t)MPR + row) * 256 + h * 64 + 8 * part);
        const u32x4 c = *(const u32x4*)(og + (2 * (size_t)MPR + row) * 256 + h * 64 + 8 * part);
        u32x4 o;
        o.x = pk2(w0 * bflo(a.x) + w1 * bflo(b.x) + w2 * bflo(c.x), w0 * bfhi(a.x) + w1 * bfhi(b.x) + w2 * bfhi(c.x));
        o.y = pk2(w0 * bflo(a.y) + w1 * bflo(b.y) + w2 * bflo(c.y), w0 * bfhi(a.y) + w1 * bfhi(b.y) + w2 * bfhi(c.y));
        o.z = pk2(w0 * bflo(a.z) + w1 * bflo(b.z) + w2 * bflo(c.z), w0 * bfhi(a.z) + w1 * bfhi(b.z) + w2 * bfhi(c.z));
        o.w = pk2(w0 * bflo(a.w) + w1 * bflo(b.w) + w2 * bflo(c.w), w0 * bfhi(a.w) + w1 * bfhi(b.w) + w2 * bfhi(c.w));
        *(u32x4*)(MIX + row * MIXW + 512 + h * 64 + 8 * part) = o;
    }
}

template <bool B> __device__ __forceinline__ void phase_rows(const Params& P, const bf16_t* mix, const bf16_t* ffn, bool x_from_input, const float* g1, const float* g2, const float* g3, const float* gnext) {
    const int tid = opaque_tid(), lane = tid & 63, wave = tid >> 6;
    const int gw = opaque_bid() * 8 + wave, NGW = gridDim.x * 8;
    bf16_t* H = (bf16_t*)(P.ws + WS_R1);
    for (int m = gw; m < MR; m += NGW) {
        const float* xr = x_from_input ? (m < MPR ? P.in[0] + (size_t)m * DM : P.in[1] + (size_t)(m - MPR) * DM) : P.out + (size_t)m * DM;
        f32x4 mv[4], xv[4], fv[4]; float s = 0.f, sf = 0.f;
#pragma unroll
        for (int j = 0; j < 4; ++j) { const u32x2 mw = *(const u32x2*)(mix + (size_t)m * DM + 4 * lane + 256 * j); mv[j] = (f32x4){bflo(mw.x), bfhi(mw.x), bflo(mw.y), bfhi(mw.y)};
            xv[j] = *(const f32x4*)(xr + 4 * lane + 256 * j); s += (mv[j].x * mv[j].x + mv[j].y * mv[j].y) + (mv[j].z * mv[j].z + mv[j].w * mv[j].w);
            if (B) { const u32x2 fw = *(const u32x2*)(ffn + (size_t)m * DM + 4 * lane + 256 * j); fv[j] = (f32x4){bflo(fw.x), bfhi(fw.x), bflo(fw.y), bfhi(fw.y)};
                sf += (fv[j].x * fv[j].x + fv[j].y * fv[j].y) + (fv[j].z * fv[j].z + fv[j].w * fv[j].w); } }
        const float r = 1.f / sqrtf(wave_sum(s) * (1.f / DM) + EPS);
        float rf = 0.f; if (B) rf = 1.f / sqrtf(wave_sum(sf) * (1.f / DM) + EPS);
        float s2 = 0.f;
#pragma unroll
        for (int j = 0; j < 4; ++j) { const f32x4 gg = *(const f32x4*)(g1 + 4 * lane + 256 * j); xv[j] = xv[j] + mv[j] * r * gg;
            if (B) { const f32x4 g3v = *(const f32x4*)(g3 + 4 * lane + 256 * j); xv[j] = xv[j] + fv[j] * rf * g3v; *(f32x4*)(P.out + (size_t)m * DM + 4 * lane + 256 * j) = xv[j]; }
            s2 += (xv[j].x * xv[j].x + xv[j].y * xv[j].y) + (xv[j].z * xv[j].z + xv[j].w * xv[j].w); }
        const float* gn = B ? gnext : g2;
        if (gn) {
            const float r2 = 1.f / sqrtf(wave_sum(s2) * (1.f / DM) + EPS);
#pragma unroll
            for (int j = 0; j < 4; ++j) { const f32x4 gg = *(const f32x4*)(gn + 4 * lane + 256 * j);
                u32x2 o; o.x = pk2(xv[j].x * r2 * gg.x, xv[j].y * r2 * gg.y); o.y = pk2(xv[j].z * r2 * gg.z, xv[j].w * r2 * gg.w);
                *(u32x2*)(H + (size_t)m * DM + 4 * lane + 256 * j) = o; }
        }
    }
}

template <int NSTEP> __device__ __forceinline__ void mini_acc(f32x4& acc, const bf16_t* ap, const bf16_t* bp) {
    bf16x8 a[NSTEP], b[NSTEP];
#pragma unroll
    for (int i = 0; i < NSTEP; ++i) { a[i] = *(const bf16x8*)(ap + 32 * i); b[i] = *(const bf16x8*)(bp + 32 * i); }
#pragma unroll
    for (int i = 0; i < NSTEP; ++i) acc = __builtin_amdgcn_mfma_f32_16x16x32_bf16(b[i], a[i], acc, 0, 0, 0);
}
template <int MODE> __device__ __forceinline__ void sample_gemm(LAS unsigned char* lds, const bf16_t* A, const bf16_t* Bt, bf16_t* O, const bf16_t* G) {
    const int tid = opaque_tid(), lane = tid & 63, w = tid >> 6, fr = lane & 15, fq = lane >> 4, kq = w & 3, half = w >> 2;
    LAS f32x4* red = (LAS f32x4*)lds;
    constexpr int LDA = MODE == 0 ? DM : (MODE == 1 ? FF : MIXW);
    for (int tile = opaque_bid() * 2 + half; tile < 512; tile += 2 * gridDim.x) {
        const int rb = tile >> 6, cb = tile & 63;
        const size_t row = (size_t)(MPR + 16 * rb + fr); const int col = 16 * cb + fr;
        const bf16_t* ap = A + row * LDA + 8 * fq; const bf16_t* bp = Bt + (size_t)col * LDA + 8 * fq;
        f32x4 acc = (f32x4){0.f, 0.f, 0.f, 0.f};
        const size_t orow = (size_t)(MPR + 16 * rb + fr); const int ocol = 16 * cb + 4 * fq;
        if constexpr (MODE == 0) { mini_acc<8>(acc, ap + 256 * kq, bp + 256 * kq); }
        else if constexpr (MODE == 1) { mini_acc<11>(acc, ap + 704 * kq, bp + 704 * kq); mini_acc<11>(acc, ap + 704 * kq + 352, bp + 704 * kq + 352); }
        else {
            f32x4 a0 = (f32x4){0.f, 0.f, 0.f, 0.f}, a1 = a0, a2 = a0;
            mini_acc<4>(a0, ap + 128 * kq, bp + 128 * kq);
            mini_acc<2>(a1, ap + 512 + 64 * kq, bp + 512 + 64 * kq);
            mini_acc<4>(a2, ap + 768 + 128 * kq, bp + 768 + 128 * kq);
            const bf16_t* gp = G + orow * GW + ocol;
            const u32x2 g0 = *(const u32x2*)gp, g1 = *(const u32x2*)(gp + DM), g2 = *(const u32x2*)(gp + 2 * DM);
            acc[0] = a0[0] * bflo(g0.x) + a1[0] * bflo(g1.x) + a2[0] * bflo(g2.x);
            acc[1] = a0[1] * bfhi(g0.x) + a1[1] * bfhi(g1.x) + a2[1] * bfhi(g2.x);
            acc[2] = a0[2] * bflo(g0.y) + a1[2] * bflo(g1.y) + a2[2] * bflo(g2.y);
            acc[3] = a0[3] * bfhi(g0.y) + a1[3] * bfhi(g1.y) + a2[3] * bfhi(g2.y);
        }
        if (kq > 0) red[(half * 3 + kq - 1) * 64 + lane] = acc;
        __syncthreads();
        if (kq == 0) {
            acc += red[(half * 3 + 0) * 64 + lane]; acc += red[(half * 3 + 1) * 64 + lane]; acc += red[(half * 3 + 2) * 64 + lane];
            u32x2 ow; ow.x = pk2(acc[0], acc[1]); ow.y = pk2(acc[2], acc[3]);
            *(u32x2*)(O + orow * DM + ocol) = ow;
        }
        __syncthreads();
    }
}

#define XB_TMO      128
#define XB_XCNT(j)  (256  + 64 * (j))
#define XB_XSUB(j)  (1280 + 64 * (j))
#define XB_XGEN(j)  (2304 + 64 * (j))
#define XB_TOP      3328
#define XB_TOPGEN   3392
#define XCD_BAR_WORDS 3456
#define XB_SPIN_CAP (1u << 18)
__device__ __forceinline__ unsigned xb_ld(unsigned* p)              { return __hip_atomic_load(p, __ATOMIC_RELAXED, __HIP_MEMORY_SCOPE_AGENT); }
__device__ __forceinline__ unsigned xb_add(unsigned* p, unsigned v) { return __hip_atomic_fetch_add(p, v, __ATOMIC_RELAXED, __HIP_MEMORY_SCOPE_AGENT); }
__device__ __forceinline__ unsigned xb_xcc_id() { return (unsigned)__builtin_amdgcn_s_getreg((3 << 11) | 20) & 0xFu; }
#define XB_SPIN(cond, bar) do { unsigned _sp = 0; while (cond) { __builtin_amdgcn_s_sleep(1); \
    if ((++_sp & 255u) == 0u) { if (xb_ld(&(bar)[XB_TMO])) break; if (_sp > XB_SPIN_CAP) { atomicAdd(&(bar)[XB_TMO], 1u); break; } } } } while (0)
struct XcdBarrier { unsigned* bar; unsigned x; volatile LAS unsigned* st; };
__device__ __forceinline__ XcdBarrier xcd_barrier_post(unsigned* bar, volatile LAS unsigned* st) {
    XcdBarrier b; b.bar = bar; b.x = xb_xcc_id(); b.st = st;
    if (threadIdx.x == 0) (void)xb_add(&bar[XB_XCNT(b.x)], 1u);
    return b;
}
__device__ __forceinline__ void xcd_barrier_complete(unsigned* bar, unsigned x, unsigned& nloc, unsigned& nx) {
    const unsigned G = gridDim.x * gridDim.y * gridDim.z;
    unsigned sum, cnt, mine, sp = 0u;
    for (;;) {
        sum = 0u; cnt = 0u; mine = 0u;
#pragma unroll
        for (unsigned j = 0; j < 16; ++j) { const unsigned c = xb_ld(&bar[XB_XCNT(j)]); sum += c; cnt += (c > 0u) ? 1u : 0u; mine = (j == x) ? c : mine; }
        if (sum == G) break;
        __builtin_amdgcn_s_sleep(1);
        if ((++sp & 255u) == 0u) { if (xb_ld(&bar[XB_TMO])) break; if (sp > XB_SPIN_CAP) { atomicAdd(&bar[XB_TMO], 1u); break; } }
    }
    nloc = mine > 0u ? mine : 1u; nx = cnt > 0u ? cnt : 1u;
}
__device__ __forceinline__ void xcd_barrier(const XcdBarrier& b) {
    asm volatile("s_waitcnt vmcnt(0)" ::: "memory");
    __syncthreads();
    if (threadIdx.x == 0) {
        unsigned* bar = b.bar;
        __builtin_amdgcn_s_waitcnt(0);
        unsigned nloc = b.st[0], nx = b.st[1];
        if (nloc == 0u) { xcd_barrier_complete(bar, b.x, nloc, nx); b.st[0] = nloc; b.st[1] = nx; }
        const unsigned old = xb_add(&bar[XB_XSUB(b.x)], 1u);
        const unsigned gen = old / nloc;
        if (old + 1u == (gen + 1u) * nloc) {
            __builtin_amdgcn_fence(__ATOMIC_RELEASE, "agent");
            asm volatile("s_waitcnt vmcnt(0)" ::: "memory");
            const unsigned og = xb_add(&bar[XB_TOP], 1u);
            const unsigned tg = og / nx;
            if (og + 1u == (tg + 1u) * nx) xb_add(&bar[XB_TOPGEN], 1u);
            else XB_SPIN(xb_ld(&bar[XB_TOPGEN]) == tg, bar);
            __builtin_amdgcn_fence(__ATOMIC_ACQUIRE, "agent");
            xb_add(&bar[XB_XGEN(b.x)], 1u);
            asm volatile("s_waitcnt vmcnt(0)" ::: "memory");
        } else {
            XB_SPIN(xb_ld(&bar[XB_XGEN(b.x)]) == gen, bar);
            __builtin_amdgcn_fence(__ATOMIC_ACQUIRE, "agent");
            asm volatile("s_waitcnt vmcnt(0)" ::: "memory");
        }
    }
    __syncthreads();
}

constexpr int PH_PER_LAYER = 9, N_PHASES = 1 + 2 * PH_PER_LAYER;
template <int PH> __device__ __forceinline__ void do_phase(const Params& P, LAS unsigned char* lds) {
    if constexpr (PH == 0) { phase_prologue(P, lds); }
    else {
        constexpr int l = (PH - 1) / PH_PER_LAYER, k = (PH - 1) % PH_PER_LAYER;
        const int G = gridDim.x;
        unsigned char* wl = P.ws + WS_W + (size_t)l * W_LAYER;
        bf16_t* R1 = (bf16_t*)(P.ws + WS_R1); bf16_t* R2 = (bf16_t*)(P.ws + WS_R2); bf16_t* R3 = (bf16_t*)(P.ws + WS_R3);
        bf16_t* Z1 = (bf16_t*)(P.ws + WS_Z1); bf16_t* GB = (bf16_t*)(P.ws + WS_G);
        pg8::StaticOrder S;
        if constexpr (k == 0) {
            pg8::Gemm g{R1, (const bf16_t*)(wl + WO_IN)}; S.init(MPAD, INW, G, opaque_bid());
            pg8::EpiIn E{Z1, GB, P.in[19] + (size_t)l * GW, P.out + O_KWIN + (size_t)l * 1048576, P.out + O_VWIN + (size_t)l * 1048576, P.out + O_KROW + (size_t)l * 32768, P.out + O_VROW + (size_t)l * 32768, (float*)(P.ws + 65536) + (size_t)l * MR * 2};
            pg8::gemm_phase<pg8::EpiIn, true, DM, DM, DM>(lds, g, S, E);
            if constexpr (l == 0) { const int nwg = (MPAD / 256) * (INW / 256); const int rounds = (nwg + G - 1) / G; const int nf = nwg - (rounds - 1) * G; const int b = opaque_bid();
                if (defer_layer1(G)) { if (G - nf >= 16) { if (b >= nf) convert_items(P, lds, 1, (b - nf) * 8 + (opaque_tid() >> 6), (G - nf) * 8, CV_SPLIT); }
                    else convert_items(P, lds, 1, b * 8 + (opaque_tid() >> 6), G * 8, CV_SPLIT); } }
        } else if constexpr (k == 1) { phase_mixer(P, lds, l); }
        else if constexpr (k == 2) { phase_combine(P); }
        else if constexpr (k == 3) {
            S.init(MPR, DM, G, opaque_bid()); pg8::Gemm g{R1, (const bf16_t*)(wl + WO_BR)}; pg8::EpiGated E{GB, R2};
            pg8::gemm_phase<pg8::EpiGated, true, MIXW, MIXW, MIXW>(lds, g, S, E);
            sample_gemm<2>(lds, R1, (const bf16_t*)(wl + WO_BR), R2, GB);
        } else if constexpr (k == 4) {
            pg8::Gemm g{R2, (const bf16_t*)(wl + WO_O)}; S.init(MPR, DM, G, opaque_bid());
            pg8::EpiBf16 E{R3, DM};
            pg8::gemm_phase<pg8::EpiBf16, true, DM, DM, DM>(lds, g, S, E);
            sample_gemm<0>(lds, R2, (const bf16_t*)(wl + WO_O), R3, nullptr);
        } else if constexpr (k == 5) { phase_rows<false>(P, R3, nullptr, l == 0, P.in[6] + (size_t)l * DM, P.in[7] + (size_t)l * DM, nullptr, nullptr); }
        else if constexpr (k == 6) {
            pg8::Gemm g{R1, (const bf16_t*)(wl + WO_GU)}; S.init(MPAD, 2 * FF, G, opaque_bid());
            pg8::EpiSwiglu E{Z1};
            pg8::gemm_phase<pg8::EpiSwiglu, true, DM, DM, DM>(lds, g, S, E);
            if constexpr (l == 0) { const int nf = up_full_blocks(G); const int b = opaque_bid();
                if (defer_layer1(G) && b >= nf) convert_items(P, lds, 1, CV_SPLIT + (b - nf) * 8 + (opaque_tid() >> 6), (G - nf) * 8); }
        } else if constexpr (k == 7) {
            pg8::Gemm g{Z1, (const bf16_t*)(wl + WO_D)}; S.init(MPR, DM, G, opaque_bid());
            pg8::EpiBf16 E{R2, DM};
            pg8::gemm_phase<pg8::EpiBf16, true, FF, FF, FF>(lds, g, S, E);
            sample_gemm<1>(lds, Z1, (const bf16_t*)(wl + WO_D), R2, nullptr);
        } else { phase_rows<true>(P, R3, R2, l == 0, P.in[6] + (size_t)l * DM, nullptr, P.in[8] + (size_t)l * DM, l + 1 < 2 ? P.in[5] + (size_t)(l + 1) * DM : nullptr); }
    }
    __syncthreads();
}

#ifndef PH_MASK
#define PH_MASK 0x7ffff
#endif
#ifndef PROBE_DUP
#define PROBE_DUP 0
#endif
#ifndef PROBE_MIX
#define PROBE_MIX 0
#endif
#ifndef PROBE_SYNCS
#define PROBE_SYNCS 0
#endif
__global__ void __launch_bounds__(512, 2) fwd_kernel(Params P) {
    extern __shared__ __attribute__((aligned(16))) unsigned char lds_raw[];
    LAS unsigned char* lds = (LAS unsigned char*)lds_raw;
    cg::grid_group grid = cg::this_grid();
    volatile LAS unsigned* stw = (volatile LAS unsigned*)(lds + LDS_BYTES - 64);
    if (threadIdx.x < 4) stw[threadIdx.x] = 0u;
    __syncthreads();
    XcdBarrier bar; bar.bar = (unsigned*)P.ws; bar.x = 0; bar.st = stw;
    if (P.ph_hi - P.ph_lo > 1) bar = xcd_barrier_post((unsigned*)P.ws, stw);
    if (P.ph_hi < 0) grid.sync();
#define RUN(ph) if (((PH_MASK >> ph) & 1) && P.ph_lo <= ph && ph < P.ph_hi) { if (ph > P.ph_lo) xcd_barrier(bar); do_phase<ph>(P, lds); if ((PROBE_DUP >> ph) & 1) { xcd_barrier(bar); do_phase<ph>(P, lds); } }
    for (int i = 0; i < PROBE_SYNCS; ++i) xcd_barrier(bar);
    RUN(0) RUN(1) RUN(2)
    if (PROBE_MIX) { xcd_barrier(bar); phase_mixer(P, lds, 0, PROBE_MIX); }
    RUN(3) RUN(4) RUN(5) RUN(6) RUN(7) RUN(8) RUN(9) RUN(10) RUN(11) RUN(12) RUN(13) RUN(14) RUN(15) RUN(16) RUN(17) RUN(18)
#undef RUN
}

extern "C" void kernel_launch(void* const* d_in, const int* in_sizes, int n_in, void* d_out, int out_size, void* d_ws, size_t ws_size, hipStream_t stream) {
    static int grid = 0;
    if (grid == 0) {
        int dev = 0, cus = 0, per_cu = 0;
        (void)hipGetDevice(&dev);
        (void)hipDeviceGetAttribute(&cus, hipDeviceAttributeMultiprocessorCount, dev);
        (void)hipFuncSetAttribute((const void*)fwd_kernel, hipFuncAttributeMaxDynamicSharedMemorySize, LDS_BYTES);
        (void)hipOccupancyMaxActiveBlocksPerMultiprocessor(&per_cu, (const void*)fwd_kernel, 512, LDS_BYTES);
        if (per_cu < 1) per_cu = 1;
        (void)hipGetLastError();
        grid = cus * 1;
        if (n_in != 24 || ws_size < WS_END) { fprintf(stderr, "kernel_launch: unexpected n_in %d / ws_size %zu\n", n_in, ws_size); }
    }
    (void)hipMemsetAsync(d_ws, 0, 524288, stream);
    Params p{};
    for (int i = 0; i < 24; ++i) p.in[i] = (const float*)d_in[i];
    p.out = (float*)d_out; p.ws = (unsigned char*)d_ws;
#if ONE_LAUNCH
    p.ph_lo = 0; p.ph_hi = N_PHASES;
    void* args[] = {&p};
    hipError_t e = hipLaunchCooperativeKernel((const void*)fwd_kernel, dim3(grid), dim3(512), args, LDS_BYTES, stream);
    if (e != hipSuccess) fprintf(stderr, "cooperative launch failed: %s (grid %d)\n", hipGetErrorString(e), grid);
#else
    for (int ph = 0; ph < N_PHASES; ++ph) {
        p.ph_lo = ph; p.ph_hi = ph + 1;
        hipLaunchKernelGGL(fwd_kernel, dim3(grid), dim3(512), LDS_BYTES, stream, p);
    }
#endif
}
```

```cpp
#include <hip/hip_runtime.h>
#include <hip/hip_cooperative_groups.h>
#include <cstdio>
#include <cstdint>
namespace cg = cooperative_groups;

#ifndef ONE_LAUNCH
#define ONE_LAUNCH 1
#endif

#define LAS __attribute__((address_space(3)))
typedef unsigned short bf16_t;
typedef short bf16x8 __attribute__((ext_vector_type(8)));
typedef short bf16x4 __attribute__((ext_vector_type(4)));
typedef float f32x4 __attribute__((ext_vector_type(4)));
typedef float f32x2 __attribute__((ext_vector_type(2)));
typedef unsigned u32x4 __attribute__((ext_vector_type(4)));
typedef unsigned u32x2 __attribute__((ext_vector_type(2)));

constexpr int DM = 1024, SEQ = 8192, MPR = 16384, MSM = 128, MR = MPR + MSM, MPAD = 16640;
constexpr int INW = 6912, ZW = 3840, GW = 3072, FF = 2816, MIXW = 1280;
constexpr size_t ZB_U = 0, ZB_GV = (size_t)MPAD * 512, ZB_Q = (size_t)MPAD * 1024, ZB_K = (size_t)MPAD * 1792, ZB_V = (size_t)MPAD * 2048, ZB_CX = (size_t)MPAD * 2304, ZB_CB = (size_t)MPAD * 2816, ZB_CC = (size_t)MPAD * 3328;
constexpr int KVP = 576;
constexpr size_t ZP_U = 512, ZP_GV = 512, ZP_Q = 768, ZP_K = 256, ZP_V = 256, ZP_CX = 512, ZP_CB = 512, ZP_CC = 512;
constexpr float EPS = 1e-6f;
constexpr size_t O_Y = 0, O_KWIN = 16908288, O_VWIN = 19005440, O_KROW = 21102592, O_VROW = 21168128, O_CONVP = 21233664, O_CONVS = 21237760, O_AV = 21303296;
constexpr size_t MiB = 1u << 20;
constexpr size_t WS_W = 1 * MiB, W_LAYER = 36 * MiB;
constexpr size_t WO_IN = 0, WO_BR = 14155776, WO_O = WO_BR + 2621440, WO_GU = WO_O + 2097152, WO_D = WO_GU + 11534336;
static_assert(WO_D + 5767168 <= W_LAYER, "weights");
constexpr size_t WS_R1 = 73 * MiB;
constexpr size_t WS_R2 = 114 * MiB;
constexpr size_t WS_R3 = 147 * MiB;
constexpr size_t WS_Z1 = 180 * MiB;
constexpr size_t WS_G = 302 * MiB;
constexpr size_t WS_END = 400 * MiB;
constexpr size_t R3_LSE = (size_t)3 * MPR * 256 * 2;

constexpr int LDS_BYTES = 147456;

__device__ __forceinline__ unsigned f2bf(float f) { unsigned u = __builtin_bit_cast(unsigned, f); return (u + 0x7fffu + ((u >> 16) & 1u)) >> 16; }
typedef __bf16 bf16x2_t __attribute__((ext_vector_type(2)));
__device__ __forceinline__ unsigned pk2(float lo, float hi) { f32x2 v = {lo, hi}; bf16x2_t b = __builtin_convertvector(v, bf16x2_t); return __builtin_bit_cast(unsigned, b); }
__device__ __forceinline__ float bflo(unsigned w) { return __builtin_bit_cast(float, w << 16); }
__device__ __forceinline__ float bfhi(unsigned w) { return __builtin_bit_cast(float, w & 0xffff0000u); }
__device__ __forceinline__ float bf1(bf16_t b) { return __builtin_bit_cast(float, (unsigned)b << 16); }
__device__ __forceinline__ float sigm(float x) { return __builtin_amdgcn_rcpf(1.f + __expf(-x)); }
__device__ __forceinline__ float gelu_t(float x) { return x * sigm(1.5957691216057308f * x * (1.f + 0.044715f * x * x)); }
__device__ __forceinline__ float wave_sum(float v) {
#pragma unroll
    for (int o = 1; o < 64; o <<= 1) v += __shfl_xor(v, o);
    return v;
}
__device__ __forceinline__ int opaque_bid() { int b = blockIdx.x; asm volatile("" : "+s"(b)); return b; }
__device__ __forceinline__ int opaque_tid() { int t = threadIdx.x; asm volatile("" : "+v"(t)); return t; }
#define LDS_WAIT() asm volatile("s_waitcnt lgkmcnt(0)" ::: "memory")

namespace pg8 {
constexpr int BM = 256, BK = 64, HALF = 128, HTB = HALF * BK * 2, STAGE_BYTES = 8 * HTB, NXCD = 8, WGM = 4;
__host__ __device__ __forceinline__ int lds_byte(int r, int c) { const int st = (r >> 4) * 2 + (c >> 5), rr = r & 15, cc = c & 31, ob = rr * 64 + cc * 2; return st * 1024 + (ob ^ (((ob >> 9) & 1) << 5)); }
__host__ __device__ __forceinline__ void stage_rc(int b, int& R, int& C) { const int st = b / 1024, sb = b % 1024, swz = sb ^ (((sb >> 9) & 1) << 5); R = (st >> 1) * 16 + swz / 64; C = (st & 1) * 32 + (swz % 64) / 2; }
__host__ __device__ __forceinline__ int perm32(int rho) { const int n = rho >> 4, i = rho & 15; return 8 * (i >> 2) + 4 * n + (i & 3); }

struct Unit { int pm, pn; };
struct Gemm { const bf16_t* A; const bf16_t* Bt; };

struct StaticOrder {
    int nM, nN, nwg, G, c;
    __host__ __device__ void init(int M, int N, int G_, int c_) { nM = M / BM; nN = N / BM; nwg = nM * nN; G = G_; c = c_; }
    __host__ __device__ bool next(int i, Unit& u) const {
        const long L = (long)i * G + c; if (L >= nwg) return false;
        int wgid = (int)L; { const int q = nwg / NXCD, r = nwg % NXCD, xcd = wgid % NXCD, off = wgid / NXCD; wgid = (xcd < r ? xcd * (q + 1) : r * (q + 1) + (xcd - r) * q) + off; }
        const int nig = WGM * nN, gid = wgid / nig, fm = gid * WGM, gsz = (nM - fm) < WGM ? (nM - fm) : WGM;
        u.pm = fm + ((wgid % nig) % gsz); u.pn = (wgid % nig) / gsz; return true;
    }
};

template <class Epi, bool ALIGN_EPI, int K_, int LDA_, int LDB_>
__device__ __forceinline__ void gemm_phase(LAS unsigned char* lds, const Gemm g, const StaticOrder& S, const Epi& E) {
    int tid_ = threadIdx.x; asm volatile("" : "+v"(tid_));
    const int tid = tid_, wid = __builtin_amdgcn_readfirstlane(tid >> 6), lane = tid & 63, wr = wid >> 2, wc = wid & 3, fr = lane & 15, fq = lane >> 4;
    constexpr int nt = K_ / BK;
    unsigned voffA[2], voffB[2];
#pragma unroll
    for (int i = 0; i < 2; ++i) { int R, C; stage_rc(tid * 16 + i * 8192, R, C); const int Rb = Epi::PERM ? ((R & ~31) + perm32(R & 31)) : R;
        voffA[i] = (unsigned)(R * LDA_ + C) * 2u; voffB[i] = (unsigned)(Rb * LDB_ + C) * 2u; }
    constexpr size_t kstep = (size_t)(BK * 2);
    constexpr size_t hstepA = (size_t)HALF * LDA_ * 2, hstepB = (size_t)HALF * LDB_ * 2;
    constexpr size_t tstepA = 2 * hstepA, tstepB = 2 * hstepB;
    const unsigned ldsw = (unsigned)wid * 1024u;
    const int aoff = lds_byte(wr * 64 + fr, fq * 8), boff = lds_byte(wc * 32 + fr, fq * 8);
#define PG8_SA(b, h) (((b) * 2 + (h)) * HTB)
#define PG8_SB(b, h) ((4 + (b) * 2 + (h)) * HTB)
#define PG8_STAGE(bufoff, gbase, voff) do { _Pragma("unroll") for (int _i = 0; _i < 2; ++_i) { unsigned _vo = (voff)[_i]; asm volatile("" : "+v"(_vo)); \
        __builtin_amdgcn_global_load_lds((const unsigned*)((const char*)(gbase) + _vo), (LAS unsigned*)(lds + (bufoff) + ldsw + _i * 8192), 16, 0, 0); } } while (0)
#define PG8_LDA(dst, b, h) do { _Pragma("unroll") for (int m = 0; m < 4; ++m) _Pragma("unroll") for (int k = 0; k < 2; ++k) dst[m][k] = *(const LAS bf16x8*)(lds + PG8_SA(b, h) + aoff + m * 2048 + k * 1024); } while (0)
#define PG8_LDB(dst, b, h) do { _Pragma("unroll") for (int n = 0; n < 2; ++n) _Pragma("unroll") for (int k = 0; k < 2; ++k) dst[n][k] = *(const LAS bf16x8*)(lds + PG8_SB(b, h) + boff + n * 2048 + k * 1024); } while (0)
#define PG8_MMA(ai, bj, At, Bt) do { __builtin_amdgcn_s_setprio(1); _Pragma("unroll") for (int m = 0; m < 4; ++m) _Pragma("unroll") for (int n = 0; n < 2; ++n) _Pragma("unroll") for (int k = 0; k < 2; ++k) \
        acc[ai][bj][m][n] = __builtin_amdgcn_mfma_f32_16x16x32_bf16(Bt[n][k], At[m][k], acc[ai][bj][m][n], 0, 0, 0); __builtin_amdgcn_s_setprio(0); } while (0)
#define PG8_WAIT_V(n) asm volatile("s_waitcnt vmcnt(" #n ")" ::: "memory")
#define PG8_WAIT_L(n) asm volatile("s_waitcnt lgkmcnt(" #n ")" ::: "memory")
#define PG8_BAR __builtin_amdgcn_s_barrier()
#define PG8_SCHED __builtin_amdgcn_sched_barrier(0)
    Unit cur, nxt; int ui = 0;
    if (!S.next(0, cur)) return;
    f32x4 acc[2][2][4][2];
#pragma unroll
    for (int a = 0; a < 2; ++a)
#pragma unroll
        for (int b = 0; b < 2; ++b)
#pragma unroll
            for (int m = 0; m < 4; ++m)
#pragma unroll
                for (int n = 0; n < 2; ++n) acc[a][b][m][n] = (f32x4){0.f, 0.f, 0.f, 0.f};
    bf16x8 At[4][2], B0[2][2], B1[2][2];
    const char* cA = (const char*)g.A + (size_t)cur.pm * tstepA; const char* cB = (const char*)g.Bt + (size_t)cur.pn * tstepB;
    PG8_SCHED; PG8_STAGE(PG8_SB(0, 0), cB, voffB); PG8_SCHED; PG8_STAGE(PG8_SB(0, 1), cB + hstepB, voffB); PG8_SCHED; PG8_STAGE(PG8_SA(0, 0), cA, voffA); PG8_SCHED; PG8_STAGE(PG8_SA(0, 1), cA + hstepA, voffA); PG8_SCHED;
    if (wr == 1) PG8_BAR;
    PG8_WAIT_V(2); PG8_BAR; PG8_SCHED;
    PG8_STAGE(PG8_SB(1, 0), cB + kstep, voffB); PG8_SCHED; PG8_STAGE(PG8_SA(1, 0), cA + kstep, voffA); PG8_SCHED; PG8_STAGE(PG8_SB(1, 1), cB + hstepB + kstep, voffB); PG8_SCHED;
    PG8_WAIT_V(6); PG8_BAR; PG8_SCHED;
    for (;;) {
        const bool has_next = S.next(ui + 1, nxt);
        const char* nA = has_next ? (const char*)g.A + (size_t)nxt.pm * tstepA : cA; const char* nB = has_next ? (const char*)g.Bt + (size_t)nxt.pn * tstepB : cB;
#define PG8_KLOOP(T0, T1) for (int t = (T0); t < (T1); t += 2) { \
            const bool last = (t == nt - 2); \
            const char* a1 = cA + (size_t)(t + 1) * kstep; \
            const char* a2 = last ? nA : cA + (size_t)(t + 2) * kstep; const char* b2 = last ? nB : cB + (size_t)(t + 2) * kstep; \
            const char* a3 = a2 + kstep; const char* b3 = b2 + kstep; \
            PG8_LDB(B0, 0, 0); PG8_LDB(B1, 0, 1); PG8_SCHED; PG8_LDA(At, 0, 0); PG8_STAGE(PG8_SA(1, 1), a1 + hstepA, voffA); \
            PG8_WAIT_V(8); PG8_WAIT_L(0); PG8_BAR; PG8_MMA(0, 0, At, B0); PG8_MMA(0, 1, At, B1); PG8_BAR; PG8_SCHED; \
            PG8_LDA(At, 0, 1); PG8_STAGE(PG8_SB(0, 0), b2, voffB); PG8_STAGE(PG8_SB(0, 1), b2 + hstepB, voffB); PG8_STAGE(PG8_SA(0, 0), a2, voffA); \
            PG8_WAIT_V(8); PG8_WAIT_L(0); PG8_BAR; PG8_MMA(1, 0, At, B0); PG8_MMA(1, 1, At, B1); PG8_BAR; PG8_SCHED; \
            PG8_LDB(B0, 1, 0); PG8_LDB(B1, 1, 1); PG8_SCHED; PG8_LDA(At, 1, 0); PG8_STAGE(PG8_SA(0, 1), a2 + hstepA, voffA); \
            PG8_WAIT_V(8); PG8_WAIT_L(0); PG8_BAR; PG8_MMA(0, 0, At, B0); PG8_MMA(0, 1, At, B1); PG8_BAR; PG8_SCHED; \
            PG8_LDA(At, 1, 1); PG8_STAGE(PG8_SB(1, 0), b3, voffB); PG8_STAGE(PG8_SB(1, 1), b3 + hstepB, voffB); PG8_STAGE(PG8_SA(1, 0), a3, voffA); \
            PG8_WAIT_V(8); PG8_WAIT_L(0); PG8_BAR; PG8_MMA(1, 0, At, B0); PG8_MMA(1, 1, At, B1); PG8_BAR; PG8_SCHED; \
        }
        if constexpr (Epi::FLUSH) { PG8_KLOOP(0, Epi::F1) E.flush(acc, cur, 0, wr, wc, fr, fq); PG8_SCHED; PG8_KLOOP(Epi::F1, Epi::F2) E.flush(acc, cur, 1, wr, wc, fr, fq); PG8_SCHED; PG8_KLOOP(Epi::F2, nt) }
        else { PG8_KLOOP(0, nt) }
#undef PG8_KLOOP
        if constexpr (ALIGN_EPI) { if (wr == 0) PG8_BAR; }
        E(acc, cur, wr, wc, fr, fq);
        if (!has_next) break;
#pragma unroll
        for (int a = 0; a < 2; ++a)
#pragma unroll
            for (int b = 0; b < 2; ++b)
#pragma unroll
                for (int m = 0; m < 4; ++m)
#pragma unroll
                    for (int n = 0; n < 2; ++n) acc[a][b][m][n] = (f32x4){0.f, 0.f, 0.f, 0.f};
        cur = nxt; cA = nA; cB = nB; ++ui;
        if constexpr (ALIGN_EPI) { if (wr == 1) PG8_BAR; }
    }
    PG8_WAIT_V(0);
    if constexpr (!ALIGN_EPI) { if (wr == 0) PG8_BAR; }
    PG8_BAR;
#undef PG8_SA
#undef PG8_SB
#undef PG8_STAGE
#undef PG8_LDA
#undef PG8_LDB
#undef PG8_MMA
#undef PG8_WAIT_V
#undef PG8_WAIT_L
#undef PG8_BAR
#undef PG8_SCHED
}

__device__ __forceinline__ u32x4 pack8(const f32x4 v0, const f32x4 v1) { u32x4 w; w.x = pk2(v0[0], v0[1]); w.y = pk2(v0[2], v0[3]); w.z = pk2(v1[0], v1[1]); w.w = pk2(v1[2], v1[3]); return w; }

struct EpiBf16 {
    static constexpr bool PERM = true, FLUSH = false;
    bf16_t* O; int ldc;
    __device__ __forceinline__ void operator()(const f32x4 (&acc)[2][2][4][2], const Unit& u, int wr, int wc, int fr, int fq) const {
        const int row0 = u.pm * BM + wr * 64 + fr, col0 = u.pn * BM + wc * 32 + 8 * fq;
#pragma unroll
        for (int ai = 0; ai < 2; ++ai)
#pragma unroll
            for (int m = 0; m < 4; ++m) { bf16_t* rowp = O + (size_t)(row0 + ai * HALF + m * 16) * ldc + col0;
#pragma unroll
                for (int bj = 0; bj < 2; ++bj) *(u32x4*)(rowp + bj * HALF) = pack8(acc[ai][bj][m][0], acc[ai][bj][m][1]); }
    }
};

struct EpiSwiglu {
    static constexpr bool PERM = true, FLUSH = false;
    bf16_t* O;
    __device__ __forceinline__ void operator()(const f32x4 (&acc)[2][2][4][2], const Unit& u, int wr, int wc, int fr, int fq) const {
        const int row0 = u.pm * BM + wr * 64 + fr, col0 = u.pn * HALF + wc * 32 + 8 * fq;
#pragma unroll
        for (int ai = 0; ai < 2; ++ai)
#pragma unroll
            for (int m = 0; m < 4; ++m) { bf16_t* rowp = O + (size_t)(row0 + ai * HALF + m * 16) * FF + col0;
                f32x4 v0, v1;
#pragma unroll
                for (int i = 0; i < 4; ++i) { const float g0 = acc[ai][0][m][0][i], g1 = acc[ai][0][m][1][i];
                    v0[i] = g0 * sigm(g0) * acc[ai][1][m][0][i]; v1[i] = g1 * sigm(g1) * acc[ai][1][m][1][i]; }
                *(u32x4*)rowp = pack8(v0, v1); }
    }
};

struct EpiGated {
    static constexpr bool PERM = true, FLUSH = true;
    static constexpr int F1 = 8, F2 = 12;
    const bf16_t* G; bf16_t* O;
    __device__ __forceinline__ void flush(f32x4 (&acc)[2][2][4][2], const Unit& u, int which, int wr, int wc, int fr, int fq) const {
        int row0 = u.pm * BM + wr * 64 + fr; asm volatile("" : "+v"(row0));
        const int col0 = u.pn * BM + wc * 32 + 8 * fq;
        const bf16_t* gbase = G + (size_t)row0 * GW + which * DM + col0; asm volatile("" : "+v"(gbase));
        u32x4 gn[2][2], gd[2][2];
#pragma unroll
        for (int bj = 0; bj < 2; ++bj) { const bf16_t* gp = gbase + bj * HALF; gn[0][bj] = *(const u32x4*)gp; gd[0][bj] = *(const u32x4*)(gp + DM); }
#pragma unroll
        for (int st = 0; st < 8; ++st) {
            const int ai = st >> 2, m = st & 3, cur = st & 1, nx = cur ^ 1;
            if (st < 7) { const int ai2 = (st + 1) >> 2, m2 = (st + 1) & 3;
#pragma unroll
                for (int bj = 0; bj < 2; ++bj) { const bf16_t* gp = gbase + (size_t)(ai2 * HALF + m2 * 16) * GW + bj * HALF; gn[nx][bj] = *(const u32x4*)gp; gd[nx][bj] = *(const u32x4*)(gp + DM); } }
#pragma unroll
            for (int bj = 0; bj < 2; ++bj) { const u32x4 a = gn[cur][bj], d = gd[cur][bj];
                float num[8] = {bflo(a.x), bfhi(a.x), bflo(a.y), bfhi(a.y), bflo(a.z), bfhi(a.z), bflo(a.w), bfhi(a.w)};
                float den[8] = {bflo(d.x), bfhi(d.x), bflo(d.y), bfhi(d.y), bflo(d.z), bfhi(d.z), bflo(d.w), bfhi(d.w)};
#pragma unroll
                for (int i = 0; i < 4; ++i) { const float n0 = which ? fmaxf(num[i], 1e-30f) : num[i], n1 = which ? fmaxf(num[4 + i], 1e-30f) : num[4 + i];
                    acc[ai][bj][m][0][i] *= n0 * __builtin_amdgcn_rcpf(fmaxf(den[i], 1e-30f)); acc[ai][bj][m][1][i] *= n1 * __builtin_amdgcn_rcpf(fmaxf(den[4 + i], 1e-30f)); } }
            __builtin_amdgcn_sched_barrier(0);
        }
    }
    __device__ __forceinline__ void operator()(const f32x4 (&acc)[2][2][4][2], const Unit& u, int wr, int wc, int fr, int fq) const {
        const int row0 = u.pm * BM + wr * 64 + fr, col0 = u.pn * BM + wc * 32 + 8 * fq;
#pragma unroll
        for (int ai = 0; ai < 2; ++ai)
#pragma unroll
            for (int m = 0; m < 4; ++m) { const size_t row = (size_t)(row0 + ai * HALF + m * 16);
#pragma unroll
                for (int bj = 0; bj < 2; ++bj) { const int col = col0 + bj * HALF;
                    const u32x4 gw = *(const u32x4*)(G + row * GW + 2 * DM + col);
                    f32x4 v0 = acc[ai][bj][m][0], v1 = acc[ai][bj][m][1];
                    v0[0] *= fmaxf(bflo(gw.x), 1e-30f); v0[1] *= fmaxf(bfhi(gw.x), 1e-30f); v0[2] *= fmaxf(bflo(gw.y), 1e-30f); v0[3] *= fmaxf(bfhi(gw.y), 1e-30f);
                    v1[0] *= fmaxf(bflo(gw.z), 1e-30f); v1[1] *= fmaxf(bfhi(gw.z), 1e-30f); v1[2] *= fmaxf(bflo(gw.w), 1e-30f); v1[3] *= fmaxf(bfhi(gw.w), 1e-30f);
                    *(u32x4*)(O + row * DM + col) = pack8(v0, v1); } }
    }
};

struct EpiIn {
    static constexpr bool PERM = true, FLUSH = false;
    bf16_t* Z1; bf16_t* G; const float* bgate; float* okwin; float* ovwin; float* okrow; float* ovrow; float* stats;
    __device__ __forceinline__ void operator()(const f32x4 (&acc)[2][2][4][2], const Unit& u, int wr, int wc, int fr, int fq) const {
        const int pn = u.pn, row0 = u.pm * BM + wr * 64 + fr, ct = wc * 32 + 8 * fq;
        if (pn == 9 || pn == 10 || pn == 13 || pn == 14) {
            const int q = pn < 11 ? pn - 9 : pn - 11;
#pragma unroll
            for (int ai = 0; ai < 2; ++ai)
#pragma unroll
                for (int m = 0; m < 4; ++m) { const int row = row0 + ai * HALF + m * 16;
                    *(u32x4*)(Z1 + ZB_CX + (size_t)row * ZP_CX + 128 * q + ct) = pack8(acc[ai][0][m][0] * acc[ai][1][m][0], acc[ai][0][m][1] * acc[ai][1][m][1]); }
        } else if (pn < 15) {
            const bool gel = pn < 4; const bool kv = (pn == 7) || (pn == 8); const bool st = (pn == 2) || (pn == 3);
            long zb; int zp, zc; const long kvoff = ((long)WS_R2 - (long)WS_Z1) / 2;
            if (pn < 2) { zb = (long)ZB_U; zp = 512; zc = pn * 256; } else if (pn < 4) { zb = (long)ZB_GV; zp = 512; zc = (pn - 2) * 256; } else if (pn < 7) { zb = (long)ZB_Q; zp = 768; zc = (pn - 4) * 256; }
            else if (pn == 7) { zb = kvoff; zp = KVP; zc = 0; } else if (pn == 8) { zb = kvoff; zp = KVP; zc = 256; } else if (pn < 11) { zb = (long)ZB_CX; zp = 512; zc = (pn - 9) * 256; }
            else if (pn < 13) { zb = (long)ZB_CB; zp = 512; zc = (pn - 11) * 256; } else { zb = (long)ZB_CC; zp = 512; zc = (pn - 13) * 256; }
#pragma unroll
            for (int ai = 0; ai < 2; ++ai)
#pragma unroll
                for (int m = 0; m < 4; ++m) { const int row = row0 + ai * HALF + m * 16; bf16_t* rowp = Z1 + (zb + (long)row * zp + zc + ct);
                    float* dst = nullptr;
                    if (kv) { if (row < MPR) { const int s = row & (SEQ - 1); if (s >= SEQ - 2048) dst = (pn == 7 ? okwin : ovwin) + (size_t)((row >> 13) * 2048 + (s - (SEQ - 2048))) * 256; }
                              else if (row < MR) dst = (pn == 7 ? okrow : ovrow) + (size_t)(row - MPR) * 256; }
                    float ssum = 0.f, qsum = 0.f;
#pragma unroll
                    for (int bj = 0; bj < 2; ++bj) { f32x4 v0 = acc[ai][bj][m][0], v1 = acc[ai][bj][m][1];
                        if (gel) {
#pragma unroll
                            for (int i = 0; i < 4; ++i) { v0[i] = gelu_t(v0[i]); v1[i] = gelu_t(v1[i]); } }
                        if (st) {
#pragma unroll
                            for (int i = 0; i < 4; ++i) { ssum += v0[i] + v1[i]; qsum += v0[i] * v0[i] + v1[i] * v1[i]; } }
                        *(u32x4*)(rowp + bj * HALF) = pack8(v0, v1);
                        if (dst) { *(f32x4*)(dst + bj * HALF + ct) = v0; *(f32x4*)(dst + bj * HALF + ct + 4) = v1; } }
                    if (st) { ssum += __shfl_xor(ssum, 16); ssum += __shfl_xor(ssum, 32); qsum += __shfl_xor(qsum, 16); qsum += __shfl_xor(qsum, 32);
                        if (fq == 0 && row < MR) { atomicAdd(stats + (size_t)row * 2, ssum); atomicAdd(stats + (size_t)row * 2 + 1, qsum); } } }
        } else {
            const int cb = (pn - 15) * BM + ct;
#pragma unroll
            for (int bj = 0; bj < 2; ++bj) { const f32x4 b0 = *(const f32x4*)(bgate + cb + bj * HALF), b1 = *(const f32x4*)(bgate + cb + bj * HALF + 4);
#pragma unroll
                for (int ai = 0; ai < 2; ++ai)
#pragma unroll
                    for (int m = 0; m < 4; ++m) { const int row = row0 + ai * HALF + m * 16; f32x4 v0 = acc[ai][bj][m][0] + b0, v1 = acc[ai][bj][m][1] + b1;
#pragma unroll
                        for (int i = 0; i < 4; ++i) { v0[i] = sigm(v0[i]); v1[i] = sigm(v1[i]); }
                        *(u32x4*)(G + (size_t)row * GW + cb + bj * HALF) = pack8(v0, v1); } }
        }
    }
};
}

struct Params { const float* in[24]; float* out; unsigned char* ws; int ph_lo, ph_hi; };

__device__ __forceinline__ void transpose_item(const float* W, int N, int k0, int n0, bf16_t* WT, int ldt, int dst_row0, int dst_col0, LAS float* scr, int lane) {
#pragma unroll 8
    for (int i = 0; i < 32; ++i) { const int kk = 2 * i + (lane >> 5); scr[kk * 33 + (lane & 31)] = W[(size_t)(k0 + kk) * N + n0 + (lane & 31)]; }
    LDS_WAIT(); asm volatile("" ::: "memory");
    const int c = lane & 7;
#pragma unroll
    for (int j = 0; j < 4; ++j) { const int n = (lane >> 3) + 8 * j; const LAS float* s = scr + (8 * c) * 33 + n;
        u32x4 o; o.x = pk2(s[0 * 33], s[1 * 33]); o.y = pk2(s[2 * 33], s[3 * 33]); o.z = pk2(s[4 * 33], s[5 * 33]); o.w = pk2(s[6 * 33], s[7 * 33]);
        *(u32x4*)(WT + (size_t)(dst_row0 + n) * ldt + dst_col0 + k0 + 8 * c) = o; }
    LDS_WAIT(); asm volatile("" ::: "memory");
}

__device__ __forceinline__ void rms_row_to_bf16(const float* xrow, const float* gain, bf16_t* orow, int lane) {
    f32x4 v[4]; float s = 0.f;
#pragma unroll
    for (int j = 0; j < 4; ++j) { v[j] = *(const f32x4*)(xrow + 4 * lane + 256 * j); s += (v[j].x * v[j].x + v[j].y * v[j].y) + (v[j].z * v[j].z + v[j].w * v[j].w); }
    const float r = 1.f / sqrtf(wave_sum(s) * (1.f / DM) + EPS);
#pragma unroll
    for (int j = 0; j < 4; ++j) { const f32x4 gg = *(const f32x4*)(gain + 4 * lane + 256 * j);
        u32x2 o; o.x = pk2(v[j].x * r * gg.x, v[j].y * r * gg.y); o.y = pk2(v[j].z * r * gg.z, v[j].w * r * gg.w);
        *(u32x2*)(orow + 4 * lane + 256 * j) = o; }
}

constexpr int CV_I_IN = 16 * 216, CV_I_BA = 8 * 32, CV_I_BB = 4 * 32, CV_I_BC = 8 * 32, CV_I_O = 16 * 32, CV_I_G = 16 * 88, CV_I_U = 16 * 88, CV_I_D = 44 * 32;
constexpr int CV_SPLIT = 2304;
constexpr int CV_PER_LAYER = CV_I_IN + CV_I_BA + CV_I_BB + CV_I_BC + CV_I_O + CV_I_G + CV_I_U + CV_I_D;
__device__ __forceinline__ void convert_items(const Params& P, LAS unsigned char* lds, int l, int it0, int stride, int it_end = CV_PER_LAYER) {
    const int tid = opaque_tid(), lane = tid & 63, wave = tid >> 6;
    LAS float* scr = (LAS float*)(lds + wave * 16384);
    unsigned char* wl = P.ws + WS_W + (size_t)l * W_LAYER;
    for (int it = it0; it < it_end; it += stride) {
        int r = it;
        if (r < CV_I_IN) { const int kb = r / 216, nb = r % 216; const int n0 = 32 * nb; int d0 = n0;
            if (n0 >= 2304 && n0 < 2816) { const int j = n0 - 2304, q = j >> 7; d0 = (q < 2 ? 9 + q : 11 + q) * 256 + (j & 127); }
            else if (n0 >= 3328 && n0 < 3840) { const int j = n0 - 3328, q = j >> 7; d0 = (q < 2 ? 9 + q : 11 + q) * 256 + 128 + (j & 127); }
            transpose_item(P.in[9] + (size_t)l * DM * INW, INW, 64 * kb, n0, (bf16_t*)(wl + WO_IN), DM, d0, 0, scr, lane); continue; } r -= CV_I_IN;
        if (r < CV_I_BA) { const int kb = r / 32, nb = r % 32; transpose_item(P.in[16] + (size_t)l * 512 * DM, DM, 64 * kb, 32 * nb, (bf16_t*)(wl + WO_BR), MIXW, 32 * nb, 0, scr, lane); continue; } r -= CV_I_BA;
        if (r < CV_I_BB) { const int kb = r / 32, nb = r % 32; transpose_item(P.in[17] + (size_t)l * 256 * DM, DM, 64 * kb, 32 * nb, (bf16_t*)(wl + WO_BR), MIXW, 32 * nb, 512, scr, lane); continue; } r -= CV_I_BB;
        if (r < CV_I_BC) { const int kb = r / 32, nb = r % 32; transpose_item(P.in[18] + (size_t)l * 512 * DM, DM, 64 * kb, 32 * nb, (bf16_t*)(wl + WO_BR), MIXW, 32 * nb, 768, scr, lane); continue; } r -= CV_I_BC;
        if (r < CV_I_O) { const int kb = r / 32, nb = r % 32; transpose_item(P.in[20] + (size_t)l * DM * DM, DM, 64 * kb, 32 * nb, (bf16_t*)(wl + WO_O), DM, 32 * nb, 0, scr, lane); continue; } r -= CV_I_O;
        if (r < CV_I_G) { const int kb = r / 88, nb = r % 88; const int n0 = 32 * nb; transpose_item(P.in[21] + (size_t)l * DM * FF, FF, 64 * kb, n0, (bf16_t*)(wl + WO_GU), DM, (n0 >> 7) * 256 + (n0 & 127), 0, scr, lane); continue; } r -= CV_I_G;
        if (r < CV_I_U) { const int kb = r / 88, nb = r % 88; const int n0 = 32 * nb; transpose_item(P.in[22] + (size_t)l * DM * FF, FF, 64 * kb, n0, (bf16_t*)(wl + WO_GU), DM, (n0 >> 7) * 256 + (n0 & 127) + 128, 0, scr, lane); continue; } r -= CV_I_U;
        { const int kb = r / 32, nb = r % 32; transpose_item(P.in[23] + (size_t)l * FF * DM, DM, 64 * kb, 32 * nb, (bf16_t*)(wl + WO_D), FF, 32 * nb, 0, scr, lane); }
    }
}
__device__ __forceinline__ int up_full_blocks(int G) { const int nwg = (MPAD / 256) * (2 * FF / 256); const int rounds = (nwg + G - 1) / G; return nwg - (rounds - 1) * G; }
__device__ __forceinline__ bool defer_layer1(int G) { const int nf = up_full_blocks(G); return (G - nf) >= 64; }
__device__ __forceinline__ void phase_prologue(const Params& P, LAS unsigned char* lds) {
    const int tid = opaque_tid(), lane = tid & 63, wave = tid >> 6;
    const int gw = opaque_bid() * 8 + wave, NGW = gridDim.x * 8;
    convert_items(P, lds, 0, gw, NGW);
    if (!defer_layer1(gridDim.x)) convert_items(P, lds, 1, gw, NGW);
    bf16_t* H = (bf16_t*)(P.ws + WS_R1);
    for (int m = gw; m < MR; m += NGW) {
        const float* xr = m < MPR ? P.in[0] + (size_t)m * DM : P.in[1] + (size_t)(m - MPR) * DM;
        rms_row_to_bf16(xr, P.in[5], H + (size_t)m * DM, lane);
    }
}

__device__ __forceinline__ float alibi_slope(int i) { return exp2f(-8.0f * (float)(i + 1) / 12.0f); }

constexpr int KS_PITCH = 72, VT_PITCH = 264;
constexpr int ATT_VT = 256 * KS_PITCH * 2, ATT_BUF = ATT_VT + 64 * VT_PITCH * 2;
struct AttnPre { u32x4 kk[4], vv[4]; bf16x8 qf[2]; };
__device__ __forceinline__ void attn_decode(int u, int& b, int& g, int& tile, int& h) { h = u & 3; tile = (u >> 2) & 63; const int bg = u >> 8; b = bg / 3; g = bg - 3 * b; }
__device__ __forceinline__ void attn_prefetch(const Params& P, int u, int tid, AttnPre& R) {
    int b, g, tile, h; attn_decode(u, b, g, tile, h);
    const int lane = tid & 63, w = tid >> 6, fr = lane & 15, fq = lane >> 4;
    const int sh = 2 * g, dil = 1 << sh, r = tile & (dil - 1), n = tile >> sh;
    const bf16_t* Z1 = (const bf16_t*)(P.ws + WS_Z1);
#pragma unroll
    for (int i = 0; i < 4; ++i) {
        const int c = tid + 512 * i, key = c >> 3, part = c & 7;
        const int jp = 128 * (n - 1) + key;
        R.kk[i] = (u32x4){0u, 0u, 0u, 0u}; R.vv[i] = (u32x4){0u, 0u, 0u, 0u};
        if (jp >= 0) { const bf16_t* rp = (const bf16_t*)(P.ws + WS_R2) + (size_t)(b * SEQ + jp * dil + r) * KVP + h * 64 + 8 * part;
            R.kk[i] = *(const u32x4*)rp; R.vv[i] = *(const u32x4*)(rp + 256); }
    }
    const int q = 16 * w + fr;
    const size_t qrow = (size_t)(b * SEQ + (128 * n + q) * dil + r);
    const bf16_t* qp = Z1 + ZB_Q + qrow * ZP_Q + (g * 4 + h) * 64 + 8 * fq; R.qf[0] = *(const bf16x8*)qp; R.qf[1] = *(const bf16x8*)(qp + 32);
}
__device__ __forceinline__ void attn_stage(LAS unsigned char* buf, int tid, const AttnPre& R) {
    LAS bf16_t* Ks = (LAS bf16_t*)buf; LAS bf16_t* Vt = (LAS bf16_t*)(buf + ATT_VT);
#pragma unroll
    for (int i = 0; i < 4; ++i) {
        const int c = tid + 512 * i, key = c >> 3, part = c & 7;
        *(LAS u32x4*)(Ks + key * KS_PITCH + 8 * part) = R.kk[i];
        LAS bf16_t* vp = Vt + (8 * part) * VT_PITCH + (key ^ (part << 3));
        const u32x4 vv = R.vv[i];
        vp[0 * VT_PITCH] = (bf16_t)(vv.x & 0xffffu); vp[1 * VT_PITCH] = (bf16_t)(vv.x >> 16);
        vp[2 * VT_PITCH] = (bf16_t)(vv.y & 0xffffu); vp[3 * VT_PITCH] = (bf16_t)(vv.y >> 16);
        vp[4 * VT_PITCH] = (bf16_t)(vv.z & 0xffffu); vp[5 * VT_PITCH] = (bf16_t)(vv.z >> 16);
        vp[6 * VT_PITCH] = (bf16_t)(vv.w & 0xffffu); vp[7 * VT_PITCH] = (bf16_t)(vv.w >> 16);
    }
}
__device__ __forceinline__ void attn_compute(const Params& P, LAS unsigned char* buf, int u, int tid, const bf16x8 (&qf)[2]) {
    int b, g, tile, h; attn_decode(u, b, g, tile, h);
    const int lane = tid & 63, w = tid >> 6, fr = lane & 15, fq = lane >> 4;
    const int sh = 2 * g, dil = 1 << sh, r = tile & (dil - 1), n = tile >> sh;
    const LAS bf16_t* Ks = (const LAS bf16_t*)buf; const LAS bf16_t* Vt = (const LAS bf16_t*)(buf + ATT_VT);
    const int q = 16 * w + fr;
    const size_t qrow = (size_t)(b * SEQ + (128 * n + q) * dil + r);
    const float sl = alibi_slope(g * 4 + h) * (float)dil;
    f32x4 sc[9];
    float mx = -INFINITY;
#pragma unroll
    for (int kb = 0; kb < 9; ++kb) {
        const LAS bf16_t* kp = Ks + (16 * (w + kb) + fr) * KS_PITCH + 8 * fq;
        f32x4 a = (f32x4){0.f, 0.f, 0.f, 0.f};
        a = __builtin_amdgcn_mfma_f32_16x16x32_bf16(*(const LAS bf16x8*)kp, qf[0], a, 0, 0, 0);
        a = __builtin_amdgcn_mfma_f32_16x16x32_bf16(*(const LAS bf16x8*)(kp + 32), qf[1], a, 0, 0, 0);
#pragma unroll
        for (int i = 0; i < 4; ++i) {
            const int dist = fr + 128 - 16 * kb - 4 * fq - i;
            const int kidx = 16 * (w + kb) + 4 * fq + i;
            const bool valid = (dist >= 0) && (dist <= 128) && (n > 0 || kidx >= 128);
            const float sv = valid ? a[i] * 0.125f - sl * (float)dist : -INFINITY;
            a[i] = sv; mx = fmaxf(mx, sv);
        }
        sc[kb] = a;
    }
    mx = fmaxf(mx, __shfl_xor(mx, 16)); mx = fmaxf(mx, __shfl_xor(mx, 32));
    float den = 0.f;
    f32x4 o[4];
#pragma unroll
    for (int d = 0; d < 4; ++d) o[d] = (f32x4){0.f, 0.f, 0.f, 0.f};
#pragma unroll
    for (int kb = 0; kb < 9; ++kb) {
        f32x4 p;
#pragma unroll
        for (int i = 0; i < 4; ++i) { p[i] = __expf(sc[kb][i] - mx); den += p[i]; }
        u32x2 pw; pw.x = pk2(p[0], p[1]); pw.y = pk2(p[2], p[3]);
        const bf16x4 pf = __builtin_bit_cast(bf16x4, pw);
#pragma unroll
        for (int d = 0; d < 4; ++d) {
            const int vrow = 16 * d + fr;
            const bf16x4 vf = *(const LAS bf16x4*)(Vt + vrow * VT_PITCH + ((16 * (w + kb) + 4 * fq) ^ (((vrow >> 3) & 7) << 3)));
            o[d] = __builtin_amdgcn_mfma_f32_16x16x16bf16_1k(vf, pf, o[d], 0, 0, 0);
        }
    }
    den += __shfl_xor(den, 16); den += __shfl_xor(den, 32);
    const float rden = 1.f / den;
    bf16_t* og = (bf16_t*)(P.ws + WS_R3) + ((size_t)g * MPR + qrow) * 256 + h * 64 + 4 * fq;
#pragma unroll
    for (int d = 0; d < 4; ++d) { u32x2 ow; ow.x = pk2(o[d][0] * rden, o[d][1] * rden); ow.y = pk2(o[d][2] * rden, o[d][3] * rden); *(u32x2*)(og + 16 * d) = ow; }
    if (fq == 0) { float* lse = (float*)(P.ws + WS_R3 + R3_LSE); lse[((size_t)g * MPR + qrow) * 4 + h] = mx + __logf(den); }
}
__device__ __forceinline__ void attn_prompt_loop(const Params& P, LAS unsigned char* lds) {
    const int tid = opaque_tid(); const int G = gridDim.x;
    int u = opaque_bid();
    if (u >= 1536) return;
    AttnPre R; attn_prefetch(P, u, tid, R);
    int buf = 0;
    for (;;) {
        bf16x8 qc[2] = {R.qf[0], R.qf[1]};
        attn_stage(lds + buf * ATT_BUF, tid, R);
        const int un = u + G;
        if (un < 1536) attn_prefetch(P, un, tid, R);
        __syncthreads();
        attn_compute(P, lds + buf * ATT_BUF, u, tid, qc);
        if (un >= 1536) break;
        u = un; buf ^= 1;
    }
    __syncthreads();
}

constexpr int SPN = 24;
constexpr size_t R3_SPO = 25 * MiB, R3_SPML = R3_SPO + (size_t)128 * SPN * 256 * 4;
__device__ __forceinline__ void attn_sample_wave(const Params& P, int l, int wu) {
    const int lane = opaque_tid() & 63, h = lane >> 4, dq = (lane & 15) * 4;
    const int qt = wu & 7, g = (wu >> 3) % 3, rt = wu / 24, db = rt >> 2, t = rt & 3;
    const bf16_t* Z1 = (const bf16_t*)(P.ws + WS_Z1);
    const size_t row = (size_t)(MPR + rt);
    const float* ck = P.in[2] + ((size_t)(l * 32 + db) * 2048) * 256 + h * 64 + dq;
    const float* cv = P.in[3] + ((size_t)(l * 32 + db) * 2048) * 256 + h * 64 + dq;
    const float* nk = P.out + O_KROW + ((size_t)(l * 128 + db * 4)) * 256 + h * 64 + dq;
    const float* nv = P.out + O_VROW + ((size_t)(l * 128 + db * 4)) * 256 + h * 64 + dq;
    const int dil = 1 << (2 * g);
    const float sl = alibi_slope(g * 4 + h) * (float)dil;
    f32x4 q4;
    { const u32x2 qw = *(const u32x2*)(Z1 + ZB_Q + row * ZP_Q + (g * 4 + h) * 64 + dq); q4 = (f32x4){bflo(qw.x), bfhi(qw.x), bflo(qw.y), bfhi(qw.y)} * 0.125f; }
    const int j0 = 17 * qt;
    f32x4 kr[17], vr[17];
#pragma unroll
    for (int i = 0; i < 17; ++i) { const int j = j0 + i; const int jj = j < 129 ? j : 128; const int idx = 2048 + t - dil * jj;
        kr[i] = *(const f32x4*)(idx < 2048 ? ck + (size_t)idx * 256 : nk + (size_t)(idx - 2048) * 256);
        vr[i] = *(const f32x4*)(idx < 2048 ? cv + (size_t)idx * 256 : nv + (size_t)(idx - 2048) * 256); }
    float sv[17]; float m = -INFINITY;
#pragma unroll
    for (int i = 0; i < 17; ++i) { const int j = j0 + i;
        float d = (q4.x * kr[i].x + q4.y * kr[i].y) + (q4.z * kr[i].z + q4.w * kr[i].w);
        d += __shfl_xor(d, 1); d += __shfl_xor(d, 2); d += __shfl_xor(d, 4); d += __shfl_xor(d, 8);
        sv[i] = j < 129 ? d - sl * (float)j : -INFINITY; m = fmaxf(m, sv[i]); }
    f32x4 o4 = (f32x4){0.f, 0.f, 0.f, 0.f}; float lsum = 0.f;
#pragma unroll
    for (int i = 0; i < 17; ++i) { const float p = __expf(sv[i] - m); lsum += p; o4 += vr[i] * p; }
    float* spo = (float*)(P.ws + WS_R3 + R3_SPO) + ((size_t)rt * SPN + g * 8 + qt) * 256 + h * 64 + dq;
    *(f32x4*)spo = o4;
    if ((lane & 15) == 0) { float* ml = (float*)(P.ws + WS_R3 + R3_SPML) + (((size_t)rt * SPN + g * 8 + qt) * 4 + h) * 2; ml[0] = m; ml[1] = lsum; }
}

constexpr int GP = 136;
constexpr int GPX = 184;
constexpr int GATE_WT = 0, GATE_RS = 128 * GP * 2, GATE_XT = GATE_RS + 512, GATE_XT_BYTES = 128 * GPX * 2;
struct GatePre { u32x4 xv[4]; f32x2 sq[4]; u32x2 uw[8]; };
__device__ __forceinline__ void gate_prefetch(const Params& P, int l, int u, int tid, GatePre& R) {
    const int chunk = u >> 2, g = u & 3; const int lane = tid & 63, w = tid >> 6, fr = lane & 15, fq = lane >> 4;
    const bf16_t* Z1 = (const bf16_t*)(P.ws + WS_Z1);
    const float* stats = (const float*)(P.ws + 65536) + (size_t)l * MR * 2;
    const size_t row0 = (size_t)chunk * 128;
#pragma unroll
    for (int i = 0; i < 4; ++i) { const int item = tid + 512 * i, ss = item >> 4, oc = item & 15;
        R.xv[i] = *(const u32x4*)(Z1 + ZB_GV + (row0 + ss) * ZP_GV + g * 128 + 8 * oc); R.sq[i] = *(const f32x2*)(stats + (row0 + ss) * 2); }
    const bf16_t* up = Z1 + ZB_U + (row0 + 16 * w + fr) * ZP_U + g * 128 + 4 * fq;
#pragma unroll
    for (int cb = 0; cb < 8; ++cb) R.uw[cb] = *(const u32x2*)(up + 16 * cb);
}
__device__ __forceinline__ void gate_stage_w(const Params& P, LAS unsigned char* lds, int l, int g, int tid) {
    LAS bf16_t* Wt = (LAS bf16_t*)(lds + GATE_WT); LAS float* rs = (LAS float*)(lds + GATE_RS);
    const float* Wsrc = P.in[12] + (size_t)(l * 4 + g) * 128 * 128;
    f32x4 wv[8];
#pragma unroll
    for (int i = 0; i < 8; ++i) wv[i] = *(const f32x4*)(Wsrc + (tid + 512 * i) * 4);
#pragma unroll
    for (int i = 0; i < 8; ++i) {
        const int e = (tid + 512 * i) * 4, tt = e >> 7, ss = e & 127;
        f32x4 x = wv[i]; x.x = ss <= tt ? x.x : 0.f; x.y = ss + 1 <= tt ? x.y : 0.f; x.z = ss + 2 <= tt ? x.z : 0.f; x.w = ss + 3 <= tt ? x.w : 0.f;
        u32x2 o; o.x = pk2(x.x, x.y); o.y = pk2(x.z, x.w);
        *(LAS u32x2*)(Wt + tt * GP + ss) = o;
        float ps = (x.x + x.y) + (x.z + x.w);
        ps += __shfl_xor(ps, 1); ps += __shfl_xor(ps, 2); ps += __shfl_xor(ps, 4); ps += __shfl_xor(ps, 8); ps += __shfl_xor(ps, 16);
        if ((tid & 31) == 0) rs[tt] = ps;
    }
}
__device__ __forceinline__ void gate_stage_x(LAS unsigned char* xbuf, int tid, const GatePre& R) {
    LAS bf16_t* VnT = (LAS bf16_t*)xbuf;
#pragma unroll
    for (int i = 0; i < 4; ++i) {
        const int item = tid + 512 * i, ss = item >> 4, oc = item & 15;
        const float mean = R.sq[i].x * (1.f / 512.f); const float var = fmaxf(R.sq[i].y * (1.f / 512.f) - mean * mean, 0.f); const float rstd = 1.f / sqrtf(var + EPS);
        const u32x4 x = R.xv[i];
        float v[8] = {bflo(x.x), bfhi(x.x), bflo(x.y), bfhi(x.y), bflo(x.z), bfhi(x.z), bflo(x.w), bfhi(x.w)};
        const int scol = ss + ((oc & 7) << 3);
#pragma unroll
        for (int e = 0; e < 8; ++e) VnT[(8 * oc + e) * GPX + scol] = (bf16_t)f2bf((v[e] - mean) * rstd);
    }
}
__device__ __forceinline__ void gate_compute(const Params& P, LAS unsigned char* lds, LAS unsigned char* xbuf, int l, int u, int tid, const u32x2 (&uw)[8]) {
    const int chunk = u >> 2, g = u & 3; const int lane = tid & 63, w = tid >> 6, fr = lane & 15, fq = lane >> 4;
    const LAS bf16_t* Wt = (const LAS bf16_t*)(lds + GATE_WT); const LAS float* rs = (const LAS float*)(lds + GATE_RS); const LAS bf16_t* VnT = (const LAS bf16_t*)xbuf;
    const int tt = 16 * w + fr;
    const float* lng = P.in[10] + l * 512 + g * 128 + 4 * fq; const float* lnb = P.in[11] + l * 512 + g * 128 + 4 * fq;
    f32x4 ga[8], be[8];
#pragma unroll
    for (int cb = 0; cb < 8; ++cb) { ga[cb] = *(const f32x4*)(lng + 16 * cb); be[cb] = *(const f32x4*)(lnb + 16 * cb); }
    const float bs = P.in[13][(size_t)(l * 4 + g) * 128 + tt];
    f32x4 acc[8];
#pragma unroll
    for (int cb = 0; cb < 8; ++cb) acc[cb] = (f32x4){0.f, 0.f, 0.f, 0.f};
    const LAS bf16_t* xlane = VnT + fr * GPX + 8 * fq + 8 * (fr >> 3);
#pragma unroll
    for (int ks = 0; ks < 4; ++ks) {
        const bf16x8 af = *(const LAS bf16x8*)(Wt + (16 * w + fr) * GP + 32 * ks + 8 * fq);
#pragma unroll
        for (int cb = 0; cb < 8; ++cb) {
            const bf16x8 bfv = *(const LAS bf16x8*)(xlane + (16 * cb * GPX + 16 * (cb & 3) + 32 * ks));
            acc[cb] = __builtin_amdgcn_mfma_f32_16x16x32_bf16(bfv, af, acc[cb], 0, 0, 0);
        }
    }
    const float rst = rs[tt];
    bf16_t* op = (bf16_t*)(P.ws + WS_R1) + ((size_t)chunk * 128 + tt) * MIXW + g * 128 + 4 * fq;
#pragma unroll
    for (int cb = 0; cb < 8; ++cb) {
        u32x2 ow; ow.x = pk2(bflo(uw[cb].x) * (ga[cb].x * acc[cb][0] + be[cb].x * rst + bs), bfhi(uw[cb].x) * (ga[cb].y * acc[cb][1] + be[cb].y * rst + bs));
        ow.y = pk2(bflo(uw[cb].y) * (ga[cb].z * acc[cb][2] + be[cb].z * rst + bs), bfhi(uw[cb].y) * (ga[cb].w * acc[cb][3] + be[cb].w * rst + bs));
        *(u32x2*)(op + 16 * cb) = ow;
    }
}
__device__ __forceinline__ void gate_prompt_loop(const Params& P, LAS unsigned char* lds, int l) {
    const int tid = opaque_tid(); const int G = gridDim.x;
    int u = opaque_bid();
    if (u >= 512) return;
    GatePre R; gate_prefetch(P, l, u, tid, R);
    int gcur = -1, buf = 0;
    for (;;) {
        if ((u & 3) != gcur) { if (gcur >= 0) __syncthreads(); gcur = u & 3; gate_stage_w(P, lds, l, gcur, tid); }
        u32x2 uc[8];
#pragma unroll
        for (int cb = 0; cb < 8; ++cb) uc[cb] = R.uw[cb];
        LAS unsigned char* xb = lds + GATE_XT + buf * GATE_XT_BYTES;
        gate_stage_x(xb, tid, R);
        const int un = u + G;
        if (un < 512) gate_prefetch(P, l, un, tid, R);
        __syncthreads();
        gate_compute(P, lds, xb, l, u, tid, uc);
        if (un >= 512) break;
        u = un; buf ^= 1;
    }
    __syncthreads();
}

__device__ __forceinline__ void sample_gc_unit(const Params& P, int l, int db) {
    const int tid = opaque_tid();
    const bf16_t* Z1 = (const bf16_t*)(P.ws + WS_Z1);
    const float* stats = (const float*)(P.ws + 65536) + (size_t)l * MR * 2;
    const size_t row0 = (size_t)(MPR + db * 4);
    const int c = tid, g = c >> 7;
    bf16_t* MIX = (bf16_t*)(P.ws + WS_R1);
    {
        const float lg = P.in[10][l * 512 + c], lb = P.in[11][l * 512 + c];
        float vn[4];
#pragma unroll
        for (int s = 0; s < 4; ++s) { const f32x2 sq = *(const f32x2*)(stats + (row0 + s) * 2);
            const float mean = sq.x * (1.f / 512.f); const float var = fmaxf(sq.y * (1.f / 512.f) - mean * mean, 0.f); const float rstd = 1.f / sqrtf(var + EPS);
            vn[s] = (bf1(Z1[ZB_GV + (row0 + s) * ZP_GV + c]) - mean) * rstd * lg + lb;
            P.out[O_AV + ((size_t)(l * 128 + db * 4 + s)) * 512 + c] = vn[s]; }
        const float* Wsrc = P.in[12] + (size_t)(l * 4 + g) * 128 * 128;
#pragma unroll
        for (int t = 0; t < 4; ++t) { float sa = P.in[13][(size_t)(l * 4 + g) * 128 + t];
#pragma unroll
            for (int s = 0; s < 4; ++s) if (s <= t) sa += Wsrc[t * 128 + s] * vn[s];
            MIX[(row0 + t) * MIXW + c] = (bf16_t)f2bf(bf1(Z1[ZB_U + (row0 + t) * ZP_U + c]) * sa); }
    }
    {
        float zp[6];
        zp[0] = P.in[4][((size_t)(l * 32 + db) * 2 + 0) * 512 + c]; zp[1] = P.in[4][((size_t)(l * 32 + db) * 2 + 1) * 512 + c];
#pragma unroll
        for (int t = 0; t < 4; ++t) zp[2 + t] = bf1(Z1[ZB_CX + (row0 + t) * ZP_CX + c]);
        const float w0 = P.in[14][(size_t)(l * 3 + 0) * 512 + c], w1 = P.in[14][(size_t)(l * 3 + 1) * 512 + c], w2 = P.in[14][(size_t)(l * 3 + 2) * 512 + c], cbias = P.in[15][l * 512 + c];
#pragma unroll
        for (int t = 0; t < 4; ++t) { const float conv = cbias + w0 * zp[t] + w1 * zp[t + 1] + w2 * zp[t + 2];
            MIX[(row0 + t) * MIXW + 768 + c] = (bf16_t)f2bf(bf1(Z1[ZB_CB + (row0 + t) * ZP_CB + c]) * conv); }
        P.out[O_CONVS + ((size_t)(l * 32 + db) * 2 + 0) * 512 + c] = zp[4];
        P.out[O_CONVS + ((size_t)(l * 32 + db) * 2 + 1) * 512 + c] = zp[5];
    }
}

__device__ __forceinline__ void conv_prompt_unit(const Params& P, int l, int rb) {
    const int tid = opaque_tid(), oc = tid & 63, rs = tid >> 6;
    const bf16_t* Z1 = (const bf16_t*)(P.ws + WS_Z1);
    bf16_t* MIX = (bf16_t*)(P.ws + WS_R1);
    const size_t row0 = (size_t)rb * 64 + rs * 8;
    const int s0 = (int)(row0 & (SEQ - 1)), bb = (int)(row0 >> 13);
    float w0[8], w1[8], w2[8], cbias[8], zm2[8], zm1[8];
    { const float* cw = P.in[14] + (size_t)l * 3 * 512 + 8 * oc; const float* cbp = P.in[15] + l * 512 + 8 * oc;
      const f32x4 a0 = *(const f32x4*)cw, a1 = *(const f32x4*)(cw + 4), b0 = *(const f32x4*)(cw + 512), b1 = *(const f32x4*)(cw + 516), c0 = *(const f32x4*)(cw + 1024), c1 = *(const f32x4*)(cw + 1028), d0 = *(const f32x4*)cbp, d1 = *(const f32x4*)(cbp + 4);
#pragma unroll
      for (int e = 0; e < 4; ++e) { w0[e] = a0[e]; w0[4 + e] = a1[e]; w1[e] = b0[e]; w1[4 + e] = b1[e]; w2[e] = c0[e]; w2[4 + e] = c1[e]; cbias[e] = d0[e]; cbias[4 + e] = d1[e]; } }
#pragma unroll
    for (int e = 0; e < 8; ++e) { zm2[e] = 0.f; zm1[e] = 0.f; }
    if (s0 >= 2) {
        const u32x4 a2 = *(const u32x4*)(Z1 + ZB_CX + (row0 - 2) * ZP_CX + 8 * oc), a1 = *(const u32x4*)(Z1 + ZB_CX + (row0 - 1) * ZP_CX + 8 * oc);
        zm2[0] = bflo(a2.x); zm2[1] = bfhi(a2.x); zm2[2] = bflo(a2.y); zm2[3] = bfhi(a2.y); zm2[4] = bflo(a2.z); zm2[5] = bfhi(a2.z); zm2[6] = bflo(a2.w); zm2[7] = bfhi(a2.w);
        zm1[0] = bflo(a1.x); zm1[1] = bfhi(a1.x); zm1[2] = bflo(a1.y); zm1[3] = bfhi(a1.y); zm1[4] = bflo(a1.z); zm1[5] = bfhi(a1.z); zm1[6] = bflo(a1.w); zm1[7] = bfhi(a1.w);
    }
#pragma unroll
    for (int i = 0; i < 8; ++i) {
        const size_t row = row0 + i;
        const u32x4 a = *(const u32x4*)(Z1 + ZB_CX + row * ZP_CX + 8 * oc), cbv = *(const u32x4*)(Z1 + ZB_CB + row * ZP_CB + 8 * oc);
        float z[8] = {bflo(a.x), bfhi(a.x), bflo(a.y), bfhi(a.y), bflo(a.z), bfhi(a.z), bflo(a.w), bfhi(a.w)};
        float cbf[8] = {bflo(cbv.x), bfhi(cbv.x), bflo(cbv.y), bfhi(cbv.y), bflo(cbv.z), bfhi(cbv.z), bflo(cbv.w), bfhi(cbv.w)};
        float oo[8];
#pragma unroll
        for (int e = 0; e < 8; ++e) { oo[e] = cbf[e] * (cbias[e] + w0[e] * zm2[e] + w1[e] * zm1[e] + w2[e] * z[e]); zm2[e] = zm1[e]; zm1[e] = z[e]; }
        u32x4 ow; ow.x = pk2(oo[0], oo[1]); ow.y = pk2(oo[2], oo[3]); ow.z = pk2(oo[4], oo[5]); ow.w = pk2(oo[6], oo[7]);
        *(u32x4*)(MIX + row * MIXW + 768 + 8 * oc) = ow;
        const int sp = s0 + i;
        if (sp >= SEQ - 2) { float* dst = P.out + O_CONVP + ((size_t)(l * 2 + bb) * 2 + (sp - (SEQ - 2))) * 512 + 8 * oc;
            *(f32x4*)dst = (f32x4){z[0], z[1], z[2], z[3]}; *(f32x4*)(dst + 4) = (f32x4){z[4], z[5], z[6], z[7]}; }
    }
}

__device__ __forceinline__ void phase_mixer(const Params& P, LAS unsigned char* lds, int l, int mask = 31) {
    const int bid = opaque_bid(), G = gridDim.x;
    if (mask & 1) { const int wv = __builtin_amdgcn_readfirstlane(opaque_tid() >> 6); const int wu0 = wv * G + bid; if (wu0 < 3072) attn_sample_wave(P, l, wu0); if (wu0 + 8 * G < 3072) attn_sample_wave(P, l, wu0 + 8 * G);
        if (G < 192) for (int wu = wu0 + 16 * G; wu < 3072; wu += G * 8) attn_sample_wave(P, l, wu); }
    const bool conv_first = (bid & 1) == 0;
    if (conv_first) { if (mask & 2) for (int u = bid; u < 32; u += G) sample_gc_unit(P, l, u);
                      if (mask & 16) for (int u = bid; u < 256; u += G) conv_prompt_unit(P, l, u); }
    if (mask & 4) gate_prompt_loop(P, lds, l);
    if (mask & 8) attn_prompt_loop(P, lds);
    if (!conv_first) { if (mask & 2) for (int u = bid; u < 32; u += G) sample_gc_unit(P, l, u);
                       if (mask & 16) for (int u = bid; u < 256; u += G) conv_prompt_unit(P, l, u); }
}

__device__ __forceinline__ void phase_combine(const Params& P) {
    const bf16_t* og = (const bf16_t*)(P.ws + WS_R3); const float* lse = (const float*)(P.ws + WS_R3 + R3_LSE);
    bf16_t* MIX = (bf16_t*)(P.ws + WS_R1);
    const int nth = gridDim.x * 512; const int gtid = opaque_bid() * 512 + opaque_tid();
    if (gtid < 128 * 64) {
        const int rt = gtid >> 6, h = (gtid >> 4) & 3, dq = (gtid & 15) * 4;
        const float* ml = (const float*)(P.ws + WS_R3 + R3_SPML) + (size_t)rt * SPN * 8 + h * 2;
        const float* spo = (const float*)(P.ws + WS_R3 + R3_SPO) + (size_t)rt * SPN * 256 + h * 64 + dq;
        float M = -INFINITY;
#pragma unroll
        for (int i = 0; i < SPN; ++i) M = fmaxf(M, ml[i * 8]);
        f32x4 acc = (f32x4){0.f, 0.f, 0.f, 0.f}; float L = 0.f;
#pragma unroll
        for (int i = 0; i < SPN; ++i) { const float f = __expf(ml[i * 8] - M); L += f * ml[i * 8 + 1]; acc += *(const f32x4*)(spo + i * 256) * f; }
        const float rl = 1.f / L;
        u32x2 ow; ow.x = pk2(acc.x * rl, acc.y * rl); ow.y = pk2(acc.z * rl, acc.w * rl);
        *(u32x2*)(MIX + (size_t)(MPR + rt) * MIXW + 512 + h * 64 + dq) = ow;
    }
    for (int idx = gtid; idx < MPR * 32; idx += nth) {
        const int part = idx & 7, h = (idx >> 3) & 3; const size_t row = (size_t)(idx >> 5);
        const float l0 = lse[(0 * (size_t)MPR + row) * 4 + h], l1 = lse[(1 * (size_t)MPR + row) * 4 + h], l2 = lse[(2 * (size_t)MPR + row) * 4 + h];
        const float m = fmaxf(l0, fmaxf(l1, l2));
        float w0 = __expf(l0 - m), w1 = __expf(l1 - m), w2 = __expf(l2 - m); const float rs = 1.f / (w0 + w1 + w2); w0 *= rs; w1 *= rs; w2 *= rs;
        const u32x4 a = *(const u32x4*)(og + (0 * (size_t)MPR + row) * 256 + h * 64 + 8 * part);
        const u32x4 b = *(const u32x4*)(og + (1 * (size_t)MPR + row) * 256 + h * 64 + 8 * part);
        const u32x4 c = *(const u32x4*)(og + (2 * (size_t)MPR + row) * 256 + h * 64 + 8 * part);
        u32x4 o;
        o.x = pk2(w0 * bflo(a.x) + w1 * bflo(b.x) + w2 * bflo(c.x), w0 * bfhi(a.x) + w1 * bfhi(b.x) + w2 * bfhi(c.x));
        o.y = pk2(w0 * bflo(a.y) + w1 * bflo(b.y) + w2 * bflo(c.y), w0 * bfhi(a.y) + w1 * bfhi(b.y) + w2 * bfhi(c.y));
        o.z = pk2(w0 * bflo(a.z) + w1 * bflo(b.z) + w2 * bflo(c.z), w0 * bfhi(a.z) + w1 * bfhi(b.z) + w2 * bfhi(c.z));
        o.w = pk2(w0 * bflo(a.w) + w1 * bflo(b.w) + w2 * bflo(c.w), w0 * bfhi(a.w) + w1 * bfhi(b.w) + w2 * bfhi(c.w));
        *(u32x4*)(MIX + row * MIXW + 512 + h * 64 + 8 * part) = o;
    }
}

template <bool B> __device__ __forceinline__ void phase_rows(const Params& P, const bf16_t* mix, const bf16_t* ffn, bool x_from_input, const float* g1, const float* g2, const float* g3, const float* gnext) {
    const int tid = opaque_tid(), lane = tid & 63, wave = tid >> 6;
    const int gw = opaque_bid() * 8 + wave, NGW = gridDim.x * 8;
    bf16_t* H = (bf16_t*)(P.ws + WS_R1);
    for (int m = gw; m < MR; m += NGW) {
        const float* xr = x_from_input ? (m < MPR ? P.in[0] + (size_t)m * DM : P.in[1] + (size_t)(m - MPR) * DM) : P.out + (size_t)m * DM;
        f32x4 mv[4], xv[4], fv[4]; float s = 0.f, sf = 0.f;
#pragma unroll
        for (int j = 0; j < 4; ++j) { const u32x2 mw = *(const u32x2*)(mix + (size_t)m * DM + 4 * lane + 256 * j); mv[j] = (f32x4){bflo(mw.x), bfhi(mw.x), bflo(mw.y), bfhi(mw.y)};
            xv[j] = *(const f32x4*)(xr + 4 * lane + 256 * j); s += (mv[j].x * mv[j].x + mv[j].y * mv[j].y) + (mv[j].z * mv[j].z + mv[j].w * mv[j].w);
            if (B) { const u32x2 fw = *(const u32x2*)(ffn + (size_t)m * DM + 4 * lane + 256 * j); fv[j] = (f32x4){bflo(fw.x), bfhi(fw.x), bflo(fw.y), bfhi(fw.y)};
                sf += (fv[j].x * fv[j].x + fv[j].y * fv[j].y) + (fv[j].z * fv[j].z + fv[j].w * fv[j].w); } }
        const float r = 1.f / sqrtf(wave_sum(s) * (1.f / DM) + EPS);
        float rf = 0.f; if (B) rf = 1.f / sqrtf(wave_sum(sf) * (1.f / DM) + EPS);
        float s2 = 0.f;
#pragma unroll
        for (int j = 0; j < 4; ++j) { const f32x4 gg = *(const f32x4*)(g1 + 4 * lane + 256 * j); xv[j] = xv[j] + mv[j] * r * gg;
            if (B) { const f32x4 g3v = *(const f32x4*)(g3 + 4 * lane + 256 * j); xv[j] = xv[j] + fv[j] * rf * g3v; *(f32x4*)(P.out + (size_t)m * DM + 4 * lane + 256 * j) = xv[j]; }
            s2 += (xv[j].x * xv[j].x + xv[j].y * xv[j].y) + (xv[j].z * xv[j].z + xv[j].w * xv[j].w); }
        const float* gn = B ? gnext : g2;
        if (gn) {
            const float r2 = 1.f / sqrtf(wave_sum(s2) * (1.f / DM) + EPS);
#pragma unroll
            for (int j = 0; j < 4; ++j) { const f32x4 gg = *(const f32x4*)(gn + 4 * lane + 256 * j);
                u32x2 o; o.x = pk2(xv[j].x * r2 * gg.x, xv[j].y * r2 * gg.y); o.y = pk2(xv[j].z * r2 * gg.z, xv[j].w * r2 * gg.w);
                *(u32x2*)(H + (size_t)m * DM + 4 * lane + 256 * j) = o; }
        }
    }
}

template <int NSTEP> __device__ __forceinline__ void mini_acc(f32x4& acc, const bf16_t* ap, const bf16_t* bp) {
    bf16x8 a[NSTEP], b[NSTEP];
#pragma unroll
    for (int i = 0; i < NSTEP; ++i) { a[i] = *(const bf16x8*)(ap + 32 * i); b[i] = *(const bf16x8*)(bp + 32 * i); }
#pragma unroll
    for (int i = 0; i < NSTEP; ++i) acc = __builtin_amdgcn_mfma_f32_16x16x32_bf16(b[i], a[i], acc, 0, 0, 0);
}
template <int MODE> __device__ __forceinline__ void sample_gemm(LAS unsigned char* lds, const bf16_t* A, const bf16_t* Bt, bf16_t* O, const bf16_t* G) {
    const int tid = opaque_tid(), lane = tid & 63, w = tid >> 6, fr = lane & 15, fq = lane >> 4, kq = w & 3, half = w >> 2;
    LAS f32x4* red = (LAS f32x4*)lds;
    constexpr int LDA = MODE == 0 ? DM : (MODE == 1 ? FF : MIXW);
    for (int tile = opaque_bid() * 2 + half; tile < 512; tile += 2 * gridDim.x) {
        const int rb = tile >> 6, cb = tile & 63;
        const size_t row = (size_t)(MPR + 16 * rb + fr); const int col = 16 * cb + fr;
        const bf16_t* ap = A + row * LDA + 8 * fq; const bf16_t* bp = Bt + (size_t)col * LDA + 8 * fq;
        f32x4 acc = (f32x4){0.f, 0.f, 0.f, 0.f};
        const size_t orow = (size_t)(MPR + 16 * rb + fr); const int ocol = 16 * cb + 4 * fq;
        if constexpr (MODE == 0) { mini_acc<8>(acc, ap + 256 * kq, bp + 256 * kq); }
        else if constexpr (MODE == 1) { mini_acc<11>(acc, ap + 704 * kq, bp + 704 * kq); mini_acc<11>(acc, ap + 704 * kq + 352, bp + 704 * kq + 352); }
        else {
            f32x4 a0 = (f32x4){0.f, 0.f, 0.f, 0.f}, a1 = a0, a2 = a0;
            mini_acc<4>(a0, ap + 128 * kq, bp + 128 * kq);
            mini_acc<2>(a1, ap + 512 + 64 * kq, bp + 512 + 64 * kq);
            mini_acc<4>(a2, ap + 768 + 128 * kq, bp + 768 + 128 * kq);
            const bf16_t* gp = G + orow * GW + ocol;
            const u32x2 g0 = *(const u32x2*)gp, g1 = *(const u32x2*)(gp + DM), g2 = *(const u32x2*)(gp + 2 * DM);
            acc[0] = a0[0] * bflo(g0.x) + a1[0] * bflo(g1.x) + a2[0] * bflo(g2.x);
            acc[1] = a0[1] * bfhi(g0.x) + a1[1] * bfhi(g1.x) + a2[1] * bfhi(g2.x);
            acc[2] = a0[2] * bflo(g0.y) + a1[2] * bflo(g1.y) + a2[2] * bflo(g2.y);
            acc[3] = a0[3] * bfhi(g0.y) + a1[3] * bfhi(g1.y) + a2[3] * bfhi(g2.y);
        }
        if (kq > 0) red[(half * 3 + kq - 1) * 64 + lane] = acc;
        __syncthreads();
        if (kq == 0) {
            acc += red[(half * 3 + 0) * 64 + lane]; acc += red[(half * 3 + 1) * 64 + lane]; acc += red[(half * 3 + 2) * 64 + lane];
            u32x2 ow; ow.x = pk2(acc[0], acc[1]); ow.y = pk2(acc[2], acc[3]);
            *(u32x2*)(O + orow * DM + ocol) = ow;
        }
        __syncthreads();
    }
}

#define XB_TMO      128
#define XB_XCNT(j)  (256  + 64 * (j))
#define XB_XSUB(j)  (1280 + 64 * (j))
#define XB_XGEN(j)  (2304 + 64 * (j))
#define XB_TOP      3328
#define XB_TOPGEN   3392
#define XCD_BAR_WORDS 3456
#define XB_SPIN_CAP (1u << 18)
__device__ __forceinline__ unsigned xb_ld(unsigned* p)              { return __hip_atomic_load(p, __ATOMIC_RELAXED, __HIP_MEMORY_SCOPE_AGENT); }
__device__ __forceinline__ unsigned xb_add(unsigned* p, unsigned v) { return __hip_atomic_fetch_add(p, v, __ATOMIC_RELAXED, __HIP_MEMORY_SCOPE_AGENT); }
__device__ __forceinline__ unsigned xb_xcc_id() { return (unsigned)__builtin_amdgcn_s_getreg((3 << 11) | 20) & 0xFu; }
#define XB_SPIN(cond, bar) do { unsigned _sp = 0; while (cond) { __builtin_amdgcn_s_sleep(1); \
    if ((++_sp & 255u) == 0u) { if (xb_ld(&(bar)[XB_TMO])) break; if (_sp > XB_SPIN_CAP) { atomicAdd(&(bar)[XB_TMO], 1u); break; } } } } while (0)
struct XcdBarrier { unsigned* bar; unsigned x; volatile LAS unsigned* st; };
__device__ __forceinline__ XcdBarrier xcd_barrier_post(unsigned* bar, volatile LAS unsigned* st) {
    XcdBarrier b; b.bar = bar; b.x = xb_xcc_id(); b.st = st;
    if (threadIdx.x == 0) (void)xb_add(&bar[XB_XCNT(b.x)], 1u);
    return b;
}
__device__ __forceinline__ void xcd_barrier_complete(unsigned* bar, unsigned x, unsigned& nloc, unsigned& nx) {
    const unsigned G = gridDim.x * gridDim.y * gridDim.z;
    unsigned sum, cnt, mine, sp = 0u;
    for (;;) {
        sum = 0u; cnt = 0u; mine = 0u;
#pragma unroll
        for (unsigned j = 0; j < 16; ++j) { const unsigned c = xb_ld(&bar[XB_XCNT(j)]); sum += c; cnt += (c > 0u) ? 1u : 0u; mine = (j == x) ? c : mine; }
        if (sum == G) break;
        __builtin_amdgcn_s_sleep(1);
        if ((++sp & 255u) == 0u) { if (xb_ld(&bar[XB_TMO])) break; if (sp > XB_SPIN_CAP) { atomicAdd(&bar[XB_TMO], 1u); break; } }
    }
    nloc = mine > 0u ? mine : 1u; nx = cnt > 0u ? cnt : 1u;
}
__device__ __forceinline__ void xcd_barrier(const XcdBarrier& b) {
    asm volatile("s_waitcnt vmcnt(0)" ::: "memory");
    __syncthreads();
    if (threadIdx.x == 0) {
        unsigned* bar = b.bar;
        __builtin_amdgcn_s_waitcnt(0);
        unsigned nloc = b.st[0], nx = b.st[1];
        if (nloc == 0u) { xcd_barrier_complete(bar, b.x, nloc, nx); b.st[0] = nloc; b.st[1] = nx; }
        const unsigned old = xb_add(&bar[XB_XSUB(b.x)], 1u);
        const unsigned gen = old / nloc;
        if (old + 1u == (gen + 1u) * nloc) {
            __builtin_amdgcn_fence(__ATOMIC_RELEASE, "agent");
            asm volatile("s_waitcnt vmcnt(0)" ::: "memory");
            const unsigned og = xb_add(&bar[XB_TOP], 1u);
            const unsigned tg = og / nx;
            if (og + 1u == (tg + 1u) * nx) xb_add(&bar[XB_TOPGEN], 1u);
            else XB_SPIN(xb_ld(&bar[XB_TOPGEN]) == tg, bar);
            __builtin_amdgcn_fence(__ATOMIC_ACQUIRE, "agent");
            xb_add(&bar[XB_XGEN(b.x)], 1u);
            asm volatile("s_waitcnt vmcnt(0)" ::: "memory");
        } else {
            XB_SPIN(xb_ld(&bar[XB_XGEN(b.x)]) == gen, bar);
            __builtin_amdgcn_fence(__ATOMIC_ACQUIRE, "agent");
            asm volatile("s_waitcnt vmcnt(0)" ::: "memory");
        }
    }
    __syncthreads();
}

constexpr int PH_PER_LAYER = 9, N_PHASES = 1 + 2 * PH_PER_LAYER;
template <int PH> __device__ __forceinline__ void do_phase(const Params& P, LAS unsigned char* lds) {
    if constexpr (PH == 0) { phase_prologue(P, lds); }
    else {
        constexpr int l = (PH - 1) / PH_PER_LAYER, k = (PH - 1) % PH_PER_LAYER;
        const int G = gridDim.x;
        unsigned char* wl = P.ws + WS_W + (size_t)l * W_LAYER;
        bf16_t* R1 = (bf16_t*)(P.ws + WS_R1); bf16_t* R2 = (bf16_t*)(P.ws + WS_R2); bf16_t* R3 = (bf16_t*)(P.ws + WS_R3);
        bf16_t* Z1 = (bf16_t*)(P.ws + WS_Z1); bf16_t* GB = (bf16_t*)(P.ws + WS_G);
        pg8::StaticOrder S;
        if constexpr (k == 0) {
            pg8::Gemm g{R1, (const bf16_t*)(wl + WO_IN)}; S.init(MPAD, INW, G, opaque_bid());
            pg8::EpiIn E{Z1, GB, P.in[19] + (size_t)l * GW, P.out + O_KWIN + (size_t)l * 1048576, P.out + O_VWIN + (size_t)l * 1048576, P.out + O_KROW + (size_t)l * 32768, P.out + O_VROW + (size_t)l * 32768, (float*)(P.ws + 65536) + (size_t)l * MR * 2};
            pg8::gemm_phase<pg8::EpiIn, true, DM, DM, DM>(lds, g, S, E);
            if constexpr (l == 0) { const int nwg = (MPAD / 256) * (INW / 256); const int rounds = (nwg + G - 1) / G; const int nf = nwg - (rounds - 1) * G; const int b = opaque_bid();
                if (defer_layer1(G)) { if (G - nf >= 16) { if (b >= nf) convert_items(P, lds, 1, (b - nf) * 8 + (opaque_tid() >> 6), (G - nf) * 8, CV_SPLIT); }
                    else convert_items(P, lds, 1, b * 8 + (opaque_tid() >> 6), G * 8, CV_SPLIT); } }
        } else if constexpr (k == 1) { phase_mixer(P, lds, l); }
        else if constexpr (k == 2) { phase_combine(P); }
        else if constexpr (k == 3) {
            S.init(MPR, DM, G, opaque_bid()); pg8::Gemm g{R1, (const bf16_t*)(wl + WO_BR)}; pg8::EpiGated E{GB, R2};
            pg8::gemm_phase<pg8::EpiGated, true, MIXW, MIXW, MIXW>(lds, g, S, E);
            sample_gemm<2>(lds, R1, (const bf16_t*)(wl + WO_BR), R2, GB);
        } else if constexpr (k == 4) {
            pg8::Gemm g{R2, (const bf16_t*)(wl + WO_O)}; S.init(MPR, DM, G, opaque_bid());
            pg8::EpiBf16 E{R3, DM};
            pg8::gemm_phase<pg8::EpiBf16, true, DM, DM, DM>(lds, g, S, E);
            sample_gemm<0>(lds, R2, (const bf16_t*)(wl + WO_O), R3, nullptr);
        } else if constexpr (k == 5) { phase_rows<false>(P, R3, nullptr, l == 0, P.in[6] + (size_t)l * DM, P.in[7] + (size_t)l * DM, nullptr, nullptr); }
        else if constexpr (k == 6) {
            pg8::Gemm g{R1, (const bf16_t*)(wl + WO_GU)}; S.init(MPAD, 2 * FF, G, opaque_bid());
            pg8::EpiSwiglu E{Z1};
            pg8::gemm_phase<pg8::EpiSwiglu, true, DM, DM, DM>(lds, g, S, E);
            if constexpr (l == 0) { const int nf = up_full_blocks(G); const int b = opaque_bid();
                if (defer_layer1(G) && b >= nf) convert_items(P, lds, 1, CV_SPLIT + (b - nf) * 8 + (opaque_tid() >> 6), (G - nf) * 8); }
        } else if constexpr (k == 7) {
            pg8::Gemm g{Z1, (const bf16_t*)(wl + WO_D)}; S.init(MPR, DM, G, opaque_bid());
            pg8::EpiBf16 E{R2, DM};
            pg8::gemm_phase<pg8::EpiBf16, true, FF, FF, FF>(lds, g, S, E);
            sample_gemm<1>(lds, Z1, (const bf16_t*)(wl + WO_D), R2, nullptr);
        } else { phase_rows<true>(P, R3, R2, l == 0, P.in[6] + (size_t)l * DM, nullptr, P.in[8] + (size_t)l * DM, l + 1 < 2 ? P.in[5] + (size_t)(l + 1) * DM : nullptr); }
    }
    __syncthreads();
}

#ifndef PH_MASK
#define PH_MASK 0x7ffff
#endif
#ifndef PROBE_DUP
#define PROBE_DUP 0
#endif
#ifndef PROBE_MIX
#define PROBE_MIX 0
#endif
#ifndef PROBE_SYNCS
#define PROBE_SYNCS 0
#endif
__global__ void __launch_bounds__(512, 2) fwd_kernel(Params P) {
    extern __shared__ __attribute__((aligned(16))) unsigned char lds_raw[];
    LAS unsigned char* lds = (LAS unsigned char*)lds_raw;
    cg::grid_group grid = cg::this_grid();
    volatile LAS unsigned* stw = (volatile LAS unsigned*)(lds + LDS_BYTES - 64);
    if (threadIdx.x < 4) stw[threadIdx.x] = 0u;
    __syncthreads();
    XcdBarrier bar; bar.bar = (unsigned*)P.ws; bar.x = 0; bar.st = stw;
    if (P.ph_hi - P.ph_lo > 1) bar = xcd_barrier_post((unsigned*)P.ws, stw);
    if (P.ph_hi < 0) grid.sync();
#define RUN(ph) if (((PH_MASK >> ph) & 1) && P.ph_lo <= ph && ph < P.ph_hi) { if (ph > P.ph_lo) xcd_barrier(bar); do_phase<ph>(P, lds); if ((PROBE_DUP >> ph) & 1) { xcd_barrier(bar); do_phase<ph>(P, lds); } }
    for (int i = 0; i < PROBE_SYNCS; ++i) xcd_barrier(bar);
    RUN(0) RUN(1) RUN(2)
    if (PROBE_MIX) { xcd_barrier(bar); phase_mixer(P, lds, 0, PROBE_MIX); }
    RUN(3) RUN(4) RUN(5) RUN(6) RUN(7) RUN(8) RUN(9) RUN(10) RUN(11) RUN(12) RUN(13) RUN(14) RUN(15) RUN(16) RUN(17) RUN(18)
#undef RUN
}

extern "C" void kernel_launch(void* const* d_in, const int* in_sizes, int n_in, void* d_out, int out_size, void* d_ws, size_t ws_size, hipStream_t stream) {
    static int grid = 0;
    if (grid == 0) {
        int dev = 0, cus = 0, per_cu = 0;
        (void)hipGetDevice(&dev);
        (void)hipDeviceGetAttribute(&cus, hipDeviceAttributeMultiprocessorCount, dev);
        (void)hipFuncSetAttribute((const void*)fwd_kernel, hipFuncAttributeMaxDynamicSharedMemorySize, LDS_BYTES);
        (void)hipOccupancyMaxActiveBlocksPerMultiprocessor(&per_cu, (const void*)fwd_kernel, 512, LDS_BYTES);
        if (per_cu < 1) per_cu = 1;
        (void)hipGetLastError();
        grid = cus * 1;
        if (n_in != 24 || ws_size < WS_END) { fprintf(stderr, "kernel_launch: unexpected n_in %d / ws_size %zu\n", n_in, ws_size); }
    }
    (void)hipMemsetAsync(d_ws, 0, 524288, stream);
    Params p{};
    for (int i = 0; i < 24; ++i) p.in[i] = (const float*)d_in[i];
    p.out = (float*)d_out; p.ws = (unsigned char*)d_ws;
#if ONE_LAUNCH
    p.ph_lo = 0; p.ph_hi = N_PHASES;
    void* args[] = {&p};
    hipError_t e = hipLaunchCooperativeKernel((const void*)fwd_kernel, dim3(grid), dim3(512), args, LDS_BYTES, stream);
    if (e != hipSuccess) fprintf(stderr, "cooperative launch failed: %s (grid %d)\n", hipGetErrorString(e), grid);
#else
    for (int ph = 0; ph < N_PHASES; ++ph) {
        p.ph_lo = ph; p.ph_hi = ph + 1;
        hipLaunchKernelGGL(fwd_kernel, dim3(grid), dim3(512), LDS_BYTES, stream, p);
    }
#endif
}
```

```cpp
#include <hip/hip_runtime.h>
#include <hip/hip_cooperative_groups.h>
#include <cstdio>
#include <cstdint>
namespace cg = cooperative_groups;

#ifndef ONE_LAUNCH
#define ONE_LAUNCH 1
#endif

#define LAS __attribute__((address_space(3)))
typedef unsigned short bf16_t;
typedef short bf16x8 __attribute__((ext_vector_type(8)));
typedef short bf16x4 __attribute__((ext_vector_type(4)));
typedef float f32x4 __attribute__((ext_vector_type(4)));
typedef float f32x2 __attribute__((ext_vector_type(2)));
typedef unsigned u32x4 __attribute__((ext_vector_type(4)));
typedef unsigned u32x2 __attribute__((ext_vector_type(2)));

constexpr int DM = 1024, SEQ = 8192, MPR = 16384, MSM = 128, MR = MPR + MSM, MPAD = 16640;
constexpr int INW = 6912, ZW = 3840, GW = 3072, FF = 2816, MIXW = 1280;
constexpr size_t ZB_U = 0, ZB_GV = (size_t)MPAD * 512, ZB_Q = (size_t)MPAD * 1024, ZB_K = (size_t)MPAD * 1792, ZB_V = (size_t)MPAD * 2048, ZB_CX = (size_t)MPAD * 2304, ZB_CB = (size_t)MPAD * 2816, ZB_CC = (size_t)MPAD * 3328;
constexpr int KVP = 576;
constexpr size_t ZP_U = 512, ZP_GV = 512, ZP_Q = 768, ZP_K = 256, ZP_V = 256, ZP_CX = 512, ZP_CB = 512, ZP_CC = 512;
constexpr float EPS = 1e-6f;
constexpr size_t O_Y = 0, O_KWIN = 16908288, O_VWIN = 19005440, O_KROW = 21102592, O_VROW = 21168128, O_CONVP = 21233664, O_CONVS = 21237760, O_AV = 21303296;
constexpr size_t MiB = 1u << 20;
constexpr size_t WS_W = 1 * MiB, W_LAYER = 36 * MiB;
constexpr size_t WO_IN = 0, WO_BR = 14155776, WO_O = WO_BR + 2621440, WO_GU = WO_O + 2097152, WO_D = WO_GU + 11534336;
static_assert(WO_D + 5767168 <= W_LAYER, "weights");
constexpr size_t WS_R1 = 73 * MiB;
constexpr size_t WS_R2 = 114 * MiB;
constexpr size_t WS_R3 = 147 * MiB;
constexpr size_t WS_Z1 = 180 * MiB;
constexpr size_t WS_G = 302 * MiB;
constexpr size_t WS_END = 400 * MiB;
constexpr size_t R3_LSE = (size_t)3 * MPR * 256 * 2;

constexpr int LDS_BYTES = 147456;

__device__ __forceinline__ unsigned f2bf(float f) { unsigned u = __builtin_bit_cast(unsigned, f); return (u + 0x7fffu + ((u >> 16) & 1u)) >> 16; }
typedef __bf16 bf16x2_t __attribute__((ext_vector_type(2)));
__device__ __forceinline__ unsigned pk2(float lo, float hi) { f32x2 v = {lo, hi}; bf16x2_t b = __builtin_convertvector(v, bf16x2_t); return __builtin_bit_cast(unsigned, b); }
__device__ __forceinline__ float bflo(unsigned w) { return __builtin_bit_cast(float, w << 16); }
__device__ __forceinline__ float bfhi(unsigned w) { return __builtin_bit_cast(float, w & 0xffff0000u); }
__device__ __forceinline__ float bf1(bf16_t b) { return __builtin_bit_cast(float, (unsigned)b << 16); }
__device__ __forceinline__ float sigm(float x) { return __builtin_amdgcn_rcpf(1.f + __expf(-x)); }
__device__ __forceinline__ float gelu_t(float x) { return x * sigm(1.5957691216057308f * x * (1.f + 0.044715f * x * x)); }
__device__ __forceinline__ float wave_sum(float v) {
#pragma unroll
    for (int o = 1; o < 64; o <<= 1) v += __shfl_xor(v, o);
    return v;
}
__device__ __forceinline__ int opaque_bid() { int b = blockIdx.x; asm volatile("" : "+s"(b)); return b; }
__device__ __forceinline__ int opaque_tid() { int t = threadIdx.x; asm volatile("" : "+v"(t)); return t; }
#define LDS_WAIT() asm volatile("s_waitcnt lgkmcnt(0)" ::: "memory")

namespace pg8 {
constexpr int BM = 256, BK = 64, HALF = 128, HTB = HALF * BK * 2, STAGE_BYTES = 8 * HTB, NXCD = 8, WGM = 4;
__host__ __device__ __forceinline__ int lds_byte(int r, int c) { const int st = (r >> 4) * 2 + (c >> 5), rr = r & 15, cc = c & 31, ob = rr * 64 + cc * 2; return st * 1024 + (ob ^ (((ob >> 9) & 1) << 5)); }
__host__ __device__ __forceinline__ void stage_rc(int b, int& R, int& C) { const int st = b / 1024, sb = b % 1024, swz = sb ^ (((sb >> 9) & 1) << 5); R = (st >> 1) * 16 + swz / 64; C = (st & 1) * 32 + (swz % 64) / 2; }
__host__ __device__ __forceinline__ int perm32(int rho) { const int n = rho >> 4, i = rho & 15; return 8 * (i >> 2) + 4 * n + (i & 3); }

struct Unit { int pm, pn; };
struct Gemm { const bf16_t* A; const bf16_t* Bt; };

struct StaticOrder {
    int nM, nN, nwg, G, c;
    __host__ __device__ void init(int M, int N, int G_, int c_) { nM = M / BM; nN = N / BM; nwg = nM * nN; G = G_; c = c_; }
    __host__ __device__ bool next(int i, Unit& u) const {
        const long L = (long)i * G + c; if (L >= nwg) return false;
        int wgid = (int)L; { const int q = nwg / NXCD, r = nwg % NXCD, xcd = wgid % NXCD, off = wgid / NXCD; wgid = (xcd < r ? xcd * (q + 1) : r * (q + 1) + (xcd - r) * q) + off; }
        const int nig = WGM * nN, gid = wgid / nig, fm = gid * WGM, gsz = (nM - fm) < WGM ? (nM - fm) : WGM;
        u.pm = fm + ((wgid % nig) % gsz); u.pn = (wgid % nig) / gsz; return true;
    }
};

template <class Epi, bool ALIGN_EPI, int K_, int LDA_, int LDB_>
__device__ __forceinline__ void gemm_phase(LAS unsigned char* lds, const Gemm g, const StaticOrder& S, const Epi& E) {
    int tid_ = threadIdx.x; asm volatile("" : "+v"(tid_));
    const int tid = tid_, wid = __builtin_amdgcn_readfirstlane(tid >> 6), lane = tid & 63, wr = wid >> 2, wc = wid & 3, fr = lane & 15, fq = lane >> 4;
    constexpr int nt = K_ / BK;
    unsigned voffA[2], voffB[2];
#pragma unroll
    for (int i = 0; i < 2; ++i) { int R, C; stage_rc(tid * 16 + i * 8192, R, C); const int Rb = Epi::PERM ? ((R & ~31) + perm32(R & 31)) : R;
        voffA[i] = (unsigned)(R * LDA_ + C) * 2u; voffB[i] = (unsigned)(Rb * LDB_ + C) * 2u; }
    constexpr size_t kstep = (size_t)(BK * 2);
    constexpr size_t hstepA = (size_t)HALF * LDA_ * 2, hstepB = (size_t)HALF * LDB_ * 2;
    constexpr size_t tstepA = 2 * hstepA, tstepB = 2 * hstepB;
    const unsigned ldsw = (unsigned)wid * 1024u;
    const int aoff = lds_byte(wr * 64 + fr, fq * 8), boff = lds_byte(wc * 32 + fr, fq * 8);
#define PG8_SA(b, h) (((b) * 2 + (h)) * HTB)
#define PG8_SB(b, h) ((4 + (b) * 2 + (h)) * HTB)
#define PG8_STAGE(bufoff, gbase, voff) do { _Pragma("unroll") for (int _i = 0; _i < 2; ++_i) { unsigned _vo = (voff)[_i]; asm volatile("" : "+v"(_vo)); \
        __builtin_amdgcn_global_load_lds((const unsigned*)((const char*)(gbase) + _vo), (LAS unsigned*)(lds + (bufoff) + ldsw + _i * 8192), 16, 0, 0); } } while (0)
#define PG8_LDA(dst, b, h) do { _Pragma("unroll") for (int m = 0; m < 4; ++m) _Pragma("unroll") for (int k = 0; k < 2; ++k) dst[m][k] = *(const LAS bf16x8*)(lds + PG8_SA(b, h) + aoff + m * 2048 + k * 1024); } while (0)
#define PG8_LDB(dst, b, h) do { _Pragma("unroll") for (int n = 0; n < 2; ++n) _Pragma("unroll") for (int k = 0; k < 2; ++k) dst[n][k] = *(const LAS bf16x8*)(lds + PG8_SB(b, h) + boff + n * 2048 + k * 1024); } while (0)
#define PG8_MMA(ai, bj, At, Bt) do { __builtin_amdgcn_s_setprio(1); _Pragma("unroll") for (int m = 0; m < 4; ++m) _Pragma("unroll") for (int n = 0; n < 2; ++n) _Pragma("unroll") for (int k = 0; k < 2; ++k) \
        acc[ai][bj][m][n] = __builtin_amdgcn_mfma_f32_16x16x32_bf16(Bt[n][k], At[m][k], acc[ai][bj][m][n], 0, 0, 0); __builtin_amdgcn_s_setprio(0); } while (0)
#define PG8_WAIT_V(n) asm volatile("s_waitcnt vmcnt(" #n ")" ::: "memory")
#define PG8_WAIT_L(n) asm volatile("s_waitcnt lgkmcnt(" #n ")" ::: "memory")
#define PG8_BAR __builtin_amdgcn_s_barrier()
#define PG8_SCHED __builtin_amdgcn_sched_barrier(0)
    Unit cur, nxt; int ui = 0;
    if (!S.next(0, cur)) return;
    f32x4 acc[2][2][4][2];
#pragma unroll
    for (int a = 0; a < 2; ++a)
#pragma unroll
        for (int b = 0; b < 2; ++b)
#pragma unroll
            for (int m = 0; m < 4; ++m)
#pragma unroll
                for (int n = 0; n < 2; ++n) acc[a][b][m][n] = (f32x4){0.f, 0.f, 0.f, 0.f};
    bf16x8 At[4][2], B0[2][2], B1[2][2];
    const char* cA = (const char*)g.A + (size_t)cur.pm * tstepA; const char* cB = (const char*)g.Bt + (size_t)cur.pn * tstepB;
    PG8_SCHED; PG8_STAGE(PG8_SB(0, 0), cB, voffB); PG8_SCHED; PG8_STAGE(PG8_SB(0, 1), cB + hstepB, voffB); PG8_SCHED; PG8_STAGE(PG8_SA(0, 0), cA, voffA); PG8_SCHED; PG8_STAGE(PG8_SA(0, 1), cA + hstepA, voffA); PG8_SCHED;
    if (wr == 1) PG8_BAR;
    PG8_WAIT_V(2); PG8_BAR; PG8_SCHED;
    PG8_STAGE(PG8_SB(1, 0), cB + kstep, voffB); PG8_SCHED; PG8_STAGE(PG8_SA(1, 0), cA + kstep, voffA); PG8_SCHED; PG8_STAGE(PG8_SB(1, 1), cB + hstepB + kstep, voffB); PG8_SCHED;
    PG8_WAIT_V(6); PG8_BAR; PG8_SCHED;
    for (;;) {
        const bool has_next = S.next(ui + 1, nxt);
        const char* nA = has_next ? (const char*)g.A + (size_t)nxt.pm * tstepA : cA; const char* nB = has_next ? (const char*)g.Bt + (size_t)nxt.pn * tstepB : cB;
#define PG8_KLOOP(T0, T1) for (int t = (T0); t < (T1); t += 2) { \
            const bool last = (t == nt - 2); \
            const char* a1 = cA + (size_t)(t + 1) * kstep; \
            const char* a2 = last ? nA : cA + (size_t)(t + 2) * kstep; const char* b2 = last ? nB : cB + (size_t)(t + 2) * kstep; \
            const char* a3 = a2 + kstep; const char* b3 = b2 + kstep; \
            PG8_LDB(B0, 0, 0); PG8_LDB(B1, 0, 1); PG8_SCHED; PG8_LDA(At, 0, 0); PG8_STAGE(PG8_SA(1, 1), a1 + hstepA, voffA); \
            PG8_WAIT_V(8); PG8_WAIT_L(0); PG8_BAR; PG8_MMA(0, 0, At, B0); PG8_MMA(0, 1, At, B1); PG8_BAR; PG8_SCHED; \
            PG8_LDA(At, 0, 1); PG8_STAGE(PG8_SB(0, 0), b2, voffB); PG8_STAGE(PG8_SB(0, 1), b2 + hstepB, voffB); PG8_STAGE(PG8_SA(0, 0), a2, voffA); \
            PG8_WAIT_V(8); PG8_WAIT_L(0); PG8_BAR; PG8_MMA(1, 0, At, B0); PG8_MMA(1, 1, At, B1); PG8_BAR; PG8_SCHED; \
            PG8_LDB(B0, 1, 0); PG8_LDB(B1, 1, 1); PG8_SCHED; PG8_LDA(At, 1, 0); PG8_STAGE(PG8_SA(0, 1), a2 + hstepA, voffA); \
            PG8_WAIT_V(8); PG8_WAIT_L(0); PG8_BAR; PG8_MMA(0, 0, At, B0); PG8_MMA(0, 1, At, B1); PG8_BAR; PG8_SCHED; \
            PG8_LDA(At, 1, 1); PG8_STAGE(PG8_SB(1, 0), b3, voffB); PG8_STAGE(PG8_SB(1, 1), b3 + hstepB, voffB); PG8_STAGE(PG8_SA(1, 0), a3, voffA); \
            PG8_WAIT_V(8); PG8_WAIT_L(0); PG8_BAR; PG8_MMA(1, 0, At, B0); PG8_MMA(1, 1, At, B1); PG8_BAR; PG8_SCHED; \
        }
        if constexpr (Epi::FLUSH) { PG8_KLOOP(0, Epi::F1) E.flush(acc, cur, 0, wr, wc, fr, fq); PG8_SCHED; PG8_KLOOP(Epi::F1, Epi::F2) E.flush(acc, cur, 1, wr, wc, fr, fq); PG8_SCHED; PG8_KLOOP(Epi::F2, nt) }
        else { PG8_KLOOP(0, nt) }
#undef PG8_KLOOP
        if constexpr (ALIGN_EPI) { if (wr == 0) PG8_BAR; }
        E(acc, cur, wr, wc, fr, fq);
        if (!has_next) break;
#pragma unroll
        for (int a = 0; a < 2; ++a)
#pragma unroll
            for (int b = 0; b < 2; ++b)
#pragma unroll
                for (int m = 0; m < 4; ++m)
#pragma unroll
                    for (int n = 0; n < 2; ++n) acc[a][b][m][n] = (f32x4){0.f, 0.f, 0.f, 0.f};
        cur = nxt; cA = nA; cB = nB; ++ui;
        if constexpr (ALIGN_EPI) { if (wr == 1) PG8_BAR; }
    }
    PG8_WAIT_V(0);
    if constexpr (!ALIGN_EPI) { if (wr == 0) PG8_BAR; }
    PG8_BAR;
#undef PG8_SA
#undef PG8_SB
#undef PG8_STAGE
#undef PG8_LDA
#undef PG8_LDB
#undef PG8_MMA
#undef PG8_WAIT_V
#undef PG8_WAIT_L
#undef PG8_BAR
#undef PG8_SCHED
}

__device__ __forceinline__ u32x4 pack8(const f32x4 v0, const f32x4 v1) { u32x4 w; w.x = pk2(v0[0], v0[1]); w.y = pk2(v0[2], v0[3]); w.z = pk2(v1[0], v1[1]); w.w = pk2(v1[2], v1[3]); return w; }

struct EpiBf16 {
    static constexpr bool PERM = true, FLUSH = false;
    bf16_t* O; int ldc;
    __device__ __forceinline__ void operator()(const f32x4 (&acc)[2][2][4][2], const Unit& u, int wr, int wc, int fr, int fq) const {
        const int row0 = u.pm * BM + wr * 64 + fr, col0 = u.pn * BM + wc * 32 + 8 * fq;
#pragma unroll
        for (int ai = 0; ai < 2; ++ai)
#pragma unroll
            for (int m = 0; m < 4; ++m) { bf16_t* rowp = O + (size_t)(row0 + ai * HALF + m * 16) * ldc + col0;
#pragma unroll
                for (int bj = 0; bj < 2; ++bj) *(u32x4*)(rowp + bj * HALF) = pack8(acc[ai][bj][m][0], acc[ai][bj][m][1]); }
    }
};

struct EpiSwiglu {
    static constexpr bool PERM = true, FLUSH = false;
    bf16_t* O;
    __device__ __forceinline__ void operator()(const f32x4 (&acc)[2][2][4][2], const Unit& u, int wr, int wc, int fr, int fq) const {
        const int row0 = u.pm * BM + wr * 64 + fr, col0 = u.pn * HALF + wc * 32 + 8 * fq;
#pragma unroll
        for (int ai = 0; ai < 2; ++ai)
#pragma unroll
            for (int m = 0; m < 4; ++m) { bf16_t* rowp = O + (size_t)(row0 + ai * HALF + m * 16) * FF + col0;
                f32x4 v0, v1;
#pragma unroll
                for (int i = 0; i < 4; ++i) { const float g0 = acc[ai][0][m][0][i], g1 = acc[ai][0][m][1][i];
                    v0[i] = g0 * sigm(g0) * acc[ai][1][m][0][i]; v1[i] = g1 * sigm(g1) * acc[ai][1][m][1][i]; }
                *(u32x4*)rowp = pack8(v0, v1); }
    }
};

struct EpiGated {
    static constexpr bool PERM = true, FLUSH = true;
    static constexpr int F1 = 8, F2 = 12;
    const bf16_t* G; bf16_t* O;
    __device__ __forceinline__ void flush(f32x4 (&acc)[2][2][4][2], const Unit& u, int which, int wr, int wc, int fr, int fq) const {
        int row0 = u.pm * BM + wr * 64 + fr; asm volatile("" : "+v"(row0));
        const int col0 = u.pn * BM + wc * 32 + 8 * fq;
        const bf16_t* gbase = G + (size_t)row0 * GW + which * DM + col0; asm volatile("" : "+v"(gbase));
        u32x4 gn[2][2], gd[2][2];
#pragma unroll
        for (int bj = 0; bj < 2; ++bj) { const bf16_t* gp = gbase + bj * HALF; gn[0][bj] = *(const u32x4*)gp; gd[0][bj] = *(const u32x4*)(gp + DM); }
#pragma unroll
        for (int st = 0; st < 8; ++st) {
            const int ai = st >> 2, m = st & 3, cur = st & 1, nx = cur ^ 1;
            if (st < 7) { const int ai2 = (st + 1) >> 2, m2 = (st + 1) & 3;
#pragma unroll
                for (int bj = 0; bj < 2; ++bj) { const bf16_t* gp = gbase + (size_t)(ai2 * HALF + m2 * 16) * GW + bj * HALF; gn[nx][bj] = *(const u32x4*)gp; gd[nx][bj] = *(const u32x4*)(gp + DM); } }
#pragma unroll
            for (int bj = 0; bj < 2; ++bj) { const u32x4 a = gn[cur][bj], d = gd[cur][bj];
                float num[8] = {bflo(a.x), bfhi(a.x), bflo(a.y), bfhi(a.y), bflo(a.z), bfhi(a.z), bflo(a.w), bfhi(a.w)};
                float den[8] = {bflo(d.x), bfhi(d.x), bflo(d.y), bfhi(d.y), bflo(d.z), bfhi(d.z), bflo(d.w), bfhi(d.w)};
#pragma unroll
                for (int i = 0; i < 4; ++i) { const float n0 = which ? fmaxf(num[i], 1e-30f) : num[i], n1 = which ? fmaxf(num[4 + i], 1e-30f) : num[4 + i];
                    acc[ai][bj][m][0][i] *= n0 * __builtin_amdgcn_rcpf(fmaxf(den[i], 1e-30f)); acc[ai][bj][m][1][i] *= n1 * __builtin_amdgcn_rcpf(fmaxf(den[4 + i], 1e-30f)); } }
            __builtin_amdgcn_sched_barrier(0);
        }
    }
    __device__ __forceinline__ void operator()(const f32x4 (&acc)[2][2][4][2], const Unit& u, int wr, int wc, int fr, int fq) const {
        const int row0 = u.pm * BM + wr * 64 + fr, col0 = u.pn * BM + wc * 32 + 8 * fq;
#pragma unroll
        for (int ai = 0; ai < 2; ++ai)
#pragma unroll
            for (int m = 0; m < 4; ++m) { const size_t row = (size_t)(row0 + ai * HALF + m * 16);
#pragma unroll
                for (int bj = 0; bj < 2; ++bj) { const int col = col0 + bj * HALF;
                    const u32x4 gw = *(const u32x4*)(G + row * GW + 2 * DM + col);
                    f32x4 v0 = acc[ai][bj][m][0], v1 = acc[ai][bj][m][1];
                    v0[0] *= fmaxf(bflo(gw.x), 1e-30f); v0[1] *= fmaxf(bfhi(gw.x), 1e-30f); v0[2] *= fmaxf(bflo(gw.y), 1e-30f); v0[3] *= fmaxf(bfhi(gw.y), 1e-30f);
                    v1[0] *= fmaxf(bflo(gw.z), 1e-30f); v1[1] *= fmaxf(bfhi(gw.z), 1e-30f); v1[2] *= fmaxf(bflo(gw.w), 1e-30f); v1[3] *= fmaxf(bfhi(gw.w), 1e-30f);
                    *(u32x4*)(O + row * DM + col) = pack8(v0, v1); } }
    }
};

struct EpiIn {
    static constexpr bool PERM = true, FLUSH = false;
    bf16_t* Z1; bf16_t* G; const float* bgate; float* okwin; float* ovwin; float* okrow; float* ovrow; float* stats;
    __device__ __forceinline__ void operator()(const f32x4 (&acc)[2][2][4][2], const Unit& u, int wr, int wc, int fr, int fq) const {
        const int pn = u.pn, row0 = u.pm * BM + wr * 64 + fr, ct = wc * 32 + 8 * fq;
        if (pn == 9 || pn == 10 || pn == 13 || pn == 14) {
            const int q = pn < 11 ? pn - 9 : pn - 11;
#pragma unroll
            for (int ai = 0; ai < 2; ++ai)
#pragma unroll
                for (int m = 0; m < 4; ++m) { const int row = row0 + ai * HALF + m * 16;
                    *(u32x4*)(Z1 + ZB_CX + (size_t)row * ZP_CX + 128 * q + ct) = pack8(acc[ai][0][m][0] * acc[ai][1][m][0], acc[ai][0][m][1] * acc[ai][1][m][1]); }
        } else if (pn < 15) {
            const bool gel = pn < 4; const bool kv = (pn == 7) || (pn == 8); const bool st = (pn == 2) || (pn == 3);
            long zb; int zp, zc; const long kvoff = ((long)WS_R2 - (long)WS_Z1) / 2;
            if (pn < 2) { zb = (long)ZB_U; zp = 512; zc = pn * 256; } else if (pn < 4) { zb = (long)ZB_GV; zp = 512; zc = (pn - 2) * 256; } else if (pn < 7) { zb = (long)ZB_Q; zp = 768; zc = (pn - 4) * 256; }
            else if (pn == 7) { zb = kvoff; zp = KVP; zc = 0; } else if (pn == 8) { zb = kvoff; zp = KVP; zc = 256; } else if (pn < 11) { zb = (long)ZB_CX; zp = 512; zc = (pn - 9) * 256; }
            else if (pn < 13) { zb = (long)ZB_CB; zp = 512; zc = (pn - 11) * 256; } else { zb = (long)ZB_CC; zp = 512; zc = (pn - 13) * 256; }
#pragma unroll
            for (int ai = 0; ai < 2; ++ai)
#pragma unroll
                for (int m = 0; m < 4; ++m) { const int row = row0 + ai * HALF + m * 16; bf16_t* rowp = Z1 + (zb + (long)row * zp + zc + ct);
                    float* dst = nullptr;
                    if (kv) { if (row < MPR) { const int s = row & (SEQ - 1); if (s >= SEQ - 2048) dst = (pn == 7 ? okwin : ovwin) + (size_t)((row >> 13) * 2048 + (s - (SEQ - 2048))) * 256; }
                              else if (row < MR) dst = (pn == 7 ? okrow : ovrow) + (size_t)(row - MPR) * 256; }
                    float ssum = 0.f, qsum = 0.f;
#pragma unroll
                    for (int bj = 0; bj < 2; ++bj) { f32x4 v0 = acc[ai][bj][m][0], v1 = acc[ai][bj][m][1];
                        if (gel) {
#pragma unroll
                            for (int i = 0; i < 4; ++i) { v0[i] = gelu_t(v0[i]); v1[i] = gelu_t(v1[i]); } }
                        if (st) {
#pragma unroll
                            for (int i = 0; i < 4; ++i) { ssum += v0[i] + v1[i]; qsum += v0[i] * v0[i] + v1[i] * v1[i]; } }
                        *(u32x4*)(rowp + bj * HALF) = pack8(v0, v1);
                        if (dst) { *(f32x4*)(dst + bj * HALF + ct) = v0; *(f32x4*)(dst + bj * HALF + ct + 4) = v1; } }
                    if (st) { ssum += __shfl_xor(ssum, 16); ssum += __shfl_xor(ssum, 32); qsum += __shfl_xor(qsum, 16); qsum += __shfl_xor(qsum, 32);
                        if (fq == 0 && row < MR) { atomicAdd(stats + (size_t)row * 2, ssum); atomicAdd(stats + (size_t)row * 2 + 1, qsum); } } }
        } else {
            const int cb = (pn - 15) * BM + ct;
#pragma unroll
            for (int bj = 0; bj < 2; ++bj) { const f32x4 b0 = *(const f32x4*)(bgate + cb + bj * HALF), b1 = *(const f32x4*)(bgate + cb + bj * HALF + 4);
#pragma unroll
                for (int ai = 0; ai < 2; ++ai)
#pragma unroll
                    for (int m = 0; m < 4; ++m) { const int row = row0 + ai * HALF + m * 16; f32x4 v0 = acc[ai][bj][m][0] + b0, v1 = acc[ai][bj][m][1] + b1;
#pragma unroll
                        for (int i = 0; i < 4; ++i) { v0[i] = sigm(v0[i]); v1[i] = sigm(v1[i]); }
                        *(u32x4*)(G + (size_t)row * GW + cb + bj * HALF) = pack8(v0, v1); } }
        }
    }
};
}

struct Params { const float* in[24]; float* out; unsigned char* ws; int ph_lo, ph_hi; };

__device__ __forceinline__ void transpose_item(const float* W, int N, int k0, int n0, bf16_t* WT, int ldt, int dst_row0, int dst_col0, LAS float* scr, int lane) {
#pragma unroll 8
    for (int i = 0; i < 32; ++i) { const int kk = 2 * i + (lane >> 5); scr[kk * 33 + (lane & 31)] = W[(size_t)(k0 + kk) * N + n0 + (lane & 31)]; }
    LDS_WAIT(); asm volatile("" ::: "memory");
    const int c = lane & 7;
#pragma unroll
    for (int j = 0; j < 4; ++j) { const int n = (lane >> 3) + 8 * j; const LAS float* s = scr + (8 * c) * 33 + n;
        u32x4 o; o.x = pk2(s[0 * 33], s[1 * 33]); o.y = pk2(s[2 * 33], s[3 * 33]); o.z = pk2(s[4 * 33], s[5 * 33]); o.w = pk2(s[6 * 33], s[7 * 33]);
        *(u32x4*)(WT + (size_t)(dst_row0 + n) * ldt + dst_col0 + k0 + 8 * c) = o; }
    LDS_WAIT(); asm volatile("" ::: "memory");
}

__device__ __forceinline__ void rms_row_to_bf16(const float* xrow, const float* gain, bf16_t* orow, int lane) {
    f32x4 v[4]; float s = 0.f;
#pragma unroll
    for (int j = 0; j < 4; ++j) { v[j] = *(const f32x4*)(xrow + 4 * lane + 256 * j); s += (v[j].x * v[j].x + v[j].y * v[j].y) + (v[j].z * v[j].z + v[j].w * v[j].w); }
    const float r = 1.f / sqrtf(wave_sum(s) * (1.f / DM) + EPS);
#pragma unroll
    for (int j = 0; j < 4; ++j) { const f32x4 gg = *(const f32x4*)(gain + 4 * lane + 256 * j);
        u32x2 o; o.x = pk2(v[j].x * r * gg.x, v[j].y * r * gg.y); o.y = pk2(v[j].z * r * gg.z, v[j].w * r * gg.w);
        *(u32x2*)(orow + 4 * lane + 256 * j) = o; }
}

constexpr int CV_I_IN = 16 * 216, CV_I_BA = 8 * 32, CV_I_BB = 4 * 32, CV_I_BC = 8 * 32, CV_I_O = 16 * 32, CV_I_G = 16 * 88, CV_I_U = 16 * 88, CV_I_D = 44 * 32;
constexpr int CV_SPLIT = 2304;
constexpr int CV_PER_LAYER = CV_I_IN + CV_I_BA + CV_I_BB + CV_I_BC + CV_I_O + CV_I_G + CV_I_U + CV_I_D;
__device__ __forceinline__ void convert_items(const Params& P, LAS unsigned char* lds, int l, int it0, int stride, int it_end = CV_PER_LAYER) {
    const int tid = opaque_tid(), lane = tid & 63, wave = tid >> 6;
    LAS float* scr = (LAS float*)(lds + wave * 16384);
    unsigned char* wl = P.ws + WS_W + (size_t)l * W_LAYER;
    for (int it = it0; it < it_end; it += stride) {
        int r = it;
        if (r < CV_I_IN) { const int kb = r / 216, nb = r % 216; const int n0 = 32 * nb; int d0 = n0;
            if (n0 >= 2304 && n0 < 2816) { const int j = n0 - 2304, q = j >> 7; d0 = (q < 2 ? 9 + q : 11 + q) * 256 + (j & 127); }
            else if (n0 >= 3328 && n0 < 3840) { const int j = n0 - 3328, q = j >> 7; d0 = (q < 2 ? 9 + q : 11 + q) * 256 + 128 + (j & 127); }
            transpose_item(P.in[9] + (size_t)l * DM * INW, INW, 64 * kb, n0, (bf16_t*)(wl + WO_IN), DM, d0, 0, scr, lane); continue; } r -= CV_I_IN;
        if (r < CV_I_BA) { const int kb = r / 32, nb = r % 32; transpose_item(P.in[16] + (size_t)l * 512 * DM, DM, 64 * kb, 32 * nb, (bf16_t*)(wl + WO_BR), MIXW, 32 * nb, 0, scr, lane); continue; } r -= CV_I_BA;
        if (r < CV_I_BB) { const int kb = r / 32, nb = r % 32; transpose_item(P.in[17] + (size_t)l * 256 * DM, DM, 64 * kb, 32 * nb, (bf16_t*)(wl + WO_BR), MIXW, 32 * nb, 512, scr, lane); continue; } r -= CV_I_BB;
        if (r < CV_I_BC) { const int kb = r / 32, nb = r % 32; transpose_item(P.in[18] + (size_t)l * 512 * DM, DM, 64 * kb, 32 * nb, (bf16_t*)(wl + WO_BR), MIXW, 32 * nb, 768, scr, lane); continue; } r -= CV_I_BC;
        if (r < CV_I_O) { const int kb = r / 32, nb = r % 32; transpose_item(P.in[20] + (size_t)l * DM * DM, DM, 64 * kb, 32 * nb, (bf16_t*)(wl + WO_O), DM, 32 * nb, 0, scr, lane); continue; } r -= CV_I_O;
        if (r < CV_I_G) { const int kb = r / 88, nb = r % 88; const int n0 = 32 * nb; transpose_item(P.in[21] + (size_t)l * DM * FF, FF, 64 * kb, n0, (bf16_t*)(wl + WO_GU), DM, (n0 >> 7) * 256 + (n0 & 127), 0, scr, lane); continue; } r -= CV_I_G;
        if (r < CV_I_U) { const int kb = r / 88, nb = r % 88; const int n0 = 32 * nb; transpose_item(P.in[22] + (size_t)l * DM * FF, FF, 64 * kb, n0, (bf16_t*)(wl + WO_GU), DM, (n0 >> 7) * 256 + (n0 & 127) + 128, 0, scr, lane); continue; } r -= CV_I_U;
        { const int kb = r / 32, nb = r % 32; transpose_item(P.in[23] + (size_t)l * FF * DM, DM, 64 * kb, 32 * nb, (bf16_t*)(wl + WO_D), FF, 32 * nb, 0, scr, lane); }
    }
}
__device__ __forceinline__ int up_full_blocks(int G) { const int nwg = (MPAD / 256) * (2 * FF / 256); const int rounds = (nwg + G - 1) / G; return nwg - (rounds - 1) * G; }
__device__ __forceinline__ bool defer_layer1(int G) { const int nf = up_full_blocks(G); return (G - nf) >= 64; }
__device__ __forceinline__ void phase_prologue(const Params& P, LAS unsigned char* lds) {
    const int tid = opaque_tid(), lane = tid & 63, wave = tid >> 6;
    const int gw = opaque_bid() * 8 + wave, NGW = gridDim.x * 8;
    convert_items(P, lds, 0, gw, NGW);
    if (!defer_layer1(gridDim.x)) convert_items(P, lds, 1, gw, NGW);
    bf16_t* H = (bf16_t*)(P.ws + WS_R1);
    for (int m = gw; m < MR; m += NGW) {
        const float* xr = m < MPR ? P.in[0] + (size_t)m * DM : P.in[1] + (size_t)(m - MPR) * DM;
        rms_row_to_bf16(xr, P.in[5], H + (size_t)m * DM, lane);
    }
}

__device__ __forceinline__ float alibi_slope(int i) { return exp2f(-8.0f * (float)(i + 1) / 12.0f); }

constexpr int KS_PITCH = 72, VT_PITCH = 264;
constexpr int ATT_VT = 256 * KS_PITCH * 2, ATT_BUF = ATT_VT + 64 * VT_PITCH * 2;
struct AttnPre { u32x4 kk[4], vv[4]; bf16x8 qf[2]; };
__device__ __forceinline__ void attn_decode(int u, int& b, int& g, int& tile, int& h) { h = u & 3; tile = (u >> 2) & 63; const int bg = u >> 8; b = bg / 3; g = bg - 3 * b; }
__device__ __forceinline__ void attn_prefetch(const Params& P, int u, int tid, AttnPre& R) {
    int b, g, tile, h; attn_decode(u, b, g, tile, h);
    const int lane = tid & 63, w = tid >> 6, fr = lane & 15, fq = lane >> 4;
    const int sh = 2 * g, dil = 1 << sh, r = tile & (dil - 1), n = tile >> sh;
    const bf16_t* Z1 = (const bf16_t*)(P.ws + WS_Z1);
#pragma unroll
    for (int i = 0; i < 4; ++i) {
        const int c = tid + 512 * i, key = c >> 3, part = c & 7;
        const int jp = 128 * (n - 1) + key;
        R.kk[i] = (u32x4){0u, 0u, 0u, 0u}; R.vv[i] = (u32x4){0u, 0u, 0u, 0u};
        if (jp >= 0) { const bf16_t* rp = (const bf16_t*)(P.ws + WS_R2) + (size_t)(b * SEQ + jp * dil + r) * KVP + h * 64 + 8 * part;
            R.kk[i] = *(const u32x4*)rp; R.vv[i] = *(const u32x4*)(rp + 256); }
    }
    const int q = 16 * w + fr;
    const size_t qrow = (size_t)(b * SEQ + (128 * n + q) * dil + r);
    const bf16_t* qp = Z1 + ZB_Q + qrow * ZP_Q + (g * 4 + h) * 64 + 8 * fq; R.qf[0] = *(const bf16x8*)qp; R.qf[1] = *(const bf16x8*)(qp + 32);
}
__device__ __forceinline__ void attn_stage(LAS unsigned char* buf, int tid, const AttnPre& R) {
    LAS bf16_t* Ks = (LAS bf16_t*)buf; LAS bf16_t* Vt = (LAS bf16_t*)(buf + ATT_VT);
#pragma unroll
    for (int i = 0; i < 4; ++i) {
        const int c = tid + 512 * i, key = c >> 3, part = c & 7;
        *(LAS u32x4*)(Ks + key * KS_PITCH + 8 * part) = R.kk[i];
        LAS bf16_t* vp = Vt + (8 * part) * VT_PITCH + (key ^ (part << 3));
        const u32x4 vv = R.vv[i];
        vp[0 * VT_PITCH] = (bf16_t)(vv.x & 0xffffu); vp[1 * VT_PITCH] = (bf16_t)(vv.x >> 16);
        vp[2 * VT_PITCH] = (bf16_t)(vv.y & 0xffffu); vp[3 * VT_PITCH] = (bf16_t)(vv.y >> 16);
        vp[4 * VT_PITCH] = (bf16_t)(vv.z & 0xffffu); vp[5 * VT_PITCH] = (bf16_t)(vv.z >> 16);
        vp[6 * VT_PITCH] = (bf16_t)(vv.w & 0xffffu); vp[7 * VT_PITCH] = (bf16_t)(vv.w >> 16);
    }
}
__device__ __forceinline__ void attn_compute(const Params& P, LAS unsigned char* buf, int u, int tid, const bf16x8 (&qf)[2]) {
    int b, g, tile, h; attn_decode(u, b, g, tile, h);
    const int lane = tid & 63, w = tid >> 6, fr = lane & 15, fq = lane >> 4;
    const int sh = 2 * g, dil = 1 << sh, r = tile & (dil - 1), n = tile >> sh;
    const LAS bf16_t* Ks = (const LAS bf16_t*)buf; const LAS bf16_t* Vt = (const LAS bf16_t*)(buf + ATT_VT);
    const int q = 16 * w + fr;
    const size_t qrow = (size_t)(b * SEQ + (128 * n + q) * dil + r);
    const float sl = alibi_slope(g * 4 + h) * (float)dil;
    f32x4 sc[9];
    float mx = -INFINITY;
#pragma unroll
    for (int kb = 0; kb < 9; ++kb) {
        const LAS bf16_t* kp = Ks + (16 * (w + kb) + fr) * KS_PITCH + 8 * fq;
        f32x4 a = (f32x4){0.f, 0.f, 0.f, 0.f};
        a = __builtin_amdgcn_mfma_f32_16x16x32_bf16(*(const LAS bf16x8*)kp, qf[0], a, 0, 0, 0);
        a = __builtin_amdgcn_mfma_f32_16x16x32_bf16(*(const LAS bf16x8*)(kp + 32), qf[1], a, 0, 0, 0);
#pragma unroll
        for (int i = 0; i < 4; ++i) {
            const int dist = fr + 128 - 16 * kb - 4 * fq - i;
            const int kidx = 16 * (w + kb) + 4 * fq + i;
            const bool valid = (dist >= 0) && (dist <= 128) && (n > 0 || kidx >= 128);
            const float sv = valid ? a[i] * 0.125f - sl * (float)dist : -INFINITY;
            a[i] = sv; mx = fmaxf(mx, sv);
        }
        sc[kb] = a;
    }
    mx = fmaxf(mx, __shfl_xor(mx, 16)); mx = fmaxf(mx, __shfl_xor(mx, 32));
    float den = 0.f;
    f32x4 o[4];
#pragma unroll
    for (int d = 0; d < 4; ++d) o[d] = (f32x4){0.f, 0.f, 0.f, 0.f};
#pragma unroll
    for (int kb = 0; kb < 9; ++kb) {
        f32x4 p;
#pragma unroll
        for (int i = 0; i < 4; ++i) { p[i] = __expf(sc[kb][i] - mx); den += p[i]; }
        u32x2 pw; pw.x = pk2(p[0], p[1]); pw.y = pk2(p[2], p[3]);
        const bf16x4 pf = __builtin_bit_cast(bf16x4, pw);
#pragma unroll
        for (int d = 0; d < 4; ++d) {
            const int vrow = 16 * d + fr;
            const bf16x4 vf = *(const LAS bf16x4*)(Vt + vrow * VT_PITCH + ((16 * (w + kb) + 4 * fq) ^ (((vrow >> 3) & 7) << 3)));
            o[d] = __builtin_amdgcn_mfma_f32_16x16x16bf16_1k(vf, pf, o[d], 0, 0, 0);
        }
    }
    den += __shfl_xor(den, 16); den += __shfl_xor(den, 32);
    const float rden = 1.f / den;
    bf16_t* og = (bf16_t*)(P.ws + WS_R3) + ((size_t)g * MPR + qrow) * 256 + h * 64 + 4 * fq;
#pragma unroll
    for (int d = 0; d < 4; ++d) { u32x2 ow; ow.x = pk2(o[d][0] * rden, o[d][1] * rden); ow.y = pk2(o[d][2] * rden, o[d][3] * rden); *(u32x2*)(og + 16 * d) = ow; }
    if (fq == 0) { float* lse = (float*)(P.ws + WS_R3 + R3_LSE); lse[((size_t)g * MPR + qrow) * 4 + h] = mx + __logf(den); }
}
__device__ __forceinline__ void attn_prompt_loop(const Params& P, LAS unsigned char* lds) {
    const int tid = opaque_tid(); const int G = gridDim.x;
    int u = opaque_bid();
    if (u >= 1536) return;
    AttnPre R; attn_prefetch(P, u, tid, R);
    int buf = 0;
    for (;;) {
        bf16x8 qc[2] = {R.qf[0], R.qf[1]};
        attn_stage(lds + buf * ATT_BUF, tid, R);
        const int un = u + G;
        if (un < 1536) attn_prefetch(P, un, tid, R);
        __syncthreads();
        attn_compute(P, lds + buf * ATT_BUF, u, tid, qc);
        if (un >= 1536) break;
        u = un; buf ^= 1;
    }
    __syncthreads();
}

constexpr int SPN = 24;
constexpr size_t R3_SPO = 25 * MiB, R3_SPML = R3_SPO + (size_t)128 * SPN * 256 * 4;
__device__ __forceinline__ void attn_sample_wave(const Params& P, int l, int wu) {
    const int lane = opaque_tid() & 63, h = lane >> 4, dq = (lane & 15) * 4;
    const int qt = wu & 7, g = (wu >> 3) % 3, rt = wu / 24, db = rt >> 2, t = rt & 3;
    const bf16_t* Z1 = (const bf16_t*)(P.ws + WS_Z1);
    const size_t row = (size_t)(MPR + rt);
    const float* ck = P.in[2] + ((size_t)(l * 32 + db) * 2048) * 256 + h * 64 + dq;
    const float* cv = P.in[3] + ((size_t)(l * 32 + db) * 2048) * 256 + h * 64 + dq;
    const float* nk = P.out + O_KROW + ((size_t)(l * 128 + db * 4)) * 256 + h * 64 + dq;
    const float* nv = P.out + O_VROW + ((size_t)(l * 128 + db * 4)) * 256 + h * 64 + dq;
    const int dil = 1 << (2 * g);
    const float sl = alibi_slope(g * 4 + h) * (float)dil;
    f32x4 q4;
    { const u32x2 qw = *(const u32x2*)(Z1 + ZB_Q + row * ZP_Q + (g * 4 + h) * 64 + dq); q4 = (f32x4){bflo(qw.x), bfhi(qw.x), bflo(qw.y), bfhi(qw.y)} * 0.125f; }
    const int j0 = 17 * qt;
    f32x4 kr[17], vr[17];
#pragma unroll
    for (int i = 0; i < 17; ++i) { const int j = j0 + i; const int jj = j < 129 ? j : 128; const int idx = 2048 + t - dil * jj;
        kr[i] = *(const f32x4*)(idx < 2048 ? ck + (size_t)idx * 256 : nk + (size_t)(idx - 2048) * 256);
        vr[i] = *(const f32x4*)(idx < 2048 ? cv + (size_t)idx * 256 : nv + (size_t)(idx - 2048) * 256); }
    float sv[17]; float m = -INFINITY;
#pragma unroll
    for (int i = 0; i < 17; ++i) { const int j = j0 + i;
        float d = (q4.x * kr[i].x + q4.y * kr[i].y) + (q4.z * kr[i].z + q4.w * kr[i].w);
        d += __shfl_xor(d, 1); d += __shfl_xor(d, 2); d += __shfl_xor(d, 4); d += __shfl_xor(d, 8);
        sv[i] = j < 129 ? d - sl * (float)j : -INFINITY; m = fmaxf(m, sv[i]); }
    f32x4 o4 = (f32x4){0.f, 0.f, 0.f, 0.f}; float lsum = 0.f;
#pragma unroll
    for (int i = 0; i < 17; ++i) { const float p = __expf(sv[i] - m); lsum += p; o4 += vr[i] * p; }
    float* spo = (float*)(P.ws + WS_R3 + R3_SPO) + ((size_t)rt * SPN + g * 8 + qt) * 256 + h * 64 + dq;
    *(f32x4*)spo = o4;
    if ((lane & 15) == 0) { float* ml = (float*)(P.ws + WS_R3 + R3_SPML) + (((size_t)rt * SPN + g * 8 + qt) * 4 + h) * 2; ml[0] = m; ml[1] = lsum; }
}

constexpr int GP = 136;
constexpr int GPX = 184;
constexpr int GATE_WT = 0, GATE_RS = 128 * GP * 2, GATE_XT = GATE_RS + 512, GATE_XT_BYTES = 128 * GPX * 2;
struct GatePre { u32x4 xv[4]; f32x2 sq[4]; u32x2 uw[8]; };
__device__ __forceinline__ void gate_prefetch(const Params& P, int l, int u, int tid, GatePre& R) {
    const int chunk = u >> 2, g = u & 3; const int lane = tid & 63, w = tid >> 6, fr = lane & 15, fq = lane >> 4;
    const bf16_t* Z1 = (const bf16_t*)(P.ws + WS_Z1);
    const float* stats = (const float*)(P.ws + 65536) + (size_t)l * MR * 2;
    const size_t row0 = (size_t)chunk * 128;
#pragma unroll
    for (int i = 0; i < 4; ++i) { const int item = tid + 512 * i, ss = item >> 4, oc = item & 15;
        R.xv[i] = *(const u32x4*)(Z1 + ZB_GV + (row0 + ss) * ZP_GV + g * 128 + 8 * oc); R.sq[i] = *(const f32x2*)(stats + (row0 + ss) * 2); }
    const bf16_t* up = Z1 + ZB_U + (row0 + 16 * w + fr) * ZP_U + g * 128 + 4 * fq;
#pragma unroll
    for (int cb = 0; cb < 8; ++cb) R.uw[cb] = *(const u32x2*)(up + 16 * cb);
}
__device__ __forceinline__ void gate_stage_w(const Params& P, LAS unsigned char* lds, int l, int g, int tid) {
    LAS bf16_t* Wt = (LAS bf16_t*)(lds + GATE_WT); LAS float* rs = (LAS float*)(lds + GATE_RS);
    const float* Wsrc = P.in[12] + (size_t)(l * 4 + g) * 128 * 128;
    f32x4 wv[8];
#pragma unroll
    for (int i = 0; i < 8; ++i) wv[i] = *(const f32x4*)(Wsrc + (tid + 512 * i) * 4);
#pragma unroll
    for (int i = 0; i < 8; ++i) {
        const int e = (tid + 512 * i) * 4, tt = e >> 7, ss = e & 127;
        f32x4 x = wv[i]; x.x = ss <= tt ? x.x : 0.f; x.y = ss + 1 <= tt ? x.y : 0.f; x.z = ss + 2 <= tt ? x.z : 0.f; x.w = ss + 3 <= tt ? x.w : 0.f;
        u32x2 o; o.x = pk2(x.x, x.y); o.y = pk2(x.z, x.w);
        *(LAS u32x2*)(Wt + tt * GP + ss) = o;
        float ps = (x.x + x.y) + (x.z + x.w);
        ps += __shfl_xor(ps, 1); ps += __shfl_xor(ps, 2); ps += __shfl_xor(ps, 4); ps += __shfl_xor(ps, 8); ps += __shfl_xor(ps, 16);
        if ((tid & 31) == 0) rs[tt] = ps;
    }
}
__device__ __forceinline__ void gate_stage_x(LAS unsigned char* xbuf, int tid, const GatePre& R) {
    LAS bf16_t* VnT = (LAS bf16_t*)xbuf;
#pragma unroll
    for (int i = 0; i < 4; ++i) {
        const int item = tid + 512 * i, ss = item >> 4, oc = item & 15;
        const float mean = R.sq[i].x * (1.f / 512.f); const float var = fmaxf(R.sq[i].y * (1.f / 512.f) - mean * mean, 0.f); const float rstd = 1.f / sqrtf(var + EPS);
        const u32x4 x = R.xv[i];
        float v[8] = {bflo(x.x), bfhi(x.x), bflo(x.y), bfhi(x.y), bflo(x.z), bfhi(x.z), bflo(x.w), bfhi(x.w)};
        const int scol = ss + ((oc & 7) << 3);
#pragma unroll
        for (int e = 0; e < 8; ++e) VnT[(8 * oc + e) * GPX + scol] = (bf16_t)f2bf((v[e] - mean) * rstd);
    }
}
__device__ __forceinline__ void gate_compute(const Params& P, LAS unsigned char* lds, LAS unsigned char* xbuf, int l, int u, int tid, const u32x2 (&uw)[8]) {
    const int chunk = u >> 2, g = u & 3; const int lane = tid & 63, w = tid >> 6, fr = lane & 15, fq = lane >> 4;
    const LAS bf16_t* Wt = (const LAS bf16_t*)(lds + GATE_WT); const LAS float* rs = (const LAS float*)(lds + GATE_RS); const LAS bf16_t* VnT = (const LAS bf16_t*)xbuf;
    const int tt = 16 * w + fr;
    const float* lng = P.in[10] + l * 512 + g * 128 + 4 * fq; const float* lnb = P.in[11] + l * 512 + g * 128 + 4 * fq;
    f32x4 ga[8], be[8];
#pragma unroll
    for (int cb = 0; cb < 8; ++cb) { ga[cb] = *(const f32x4*)(lng + 16 * cb); be[cb] = *(const f32x4*)(lnb + 16 * cb); }
    const float bs = P.in[13][(size_t)(l * 4 + g) * 128 + tt];
    f32x4 acc[8];
#pragma unroll
    for (int cb = 0; cb < 8; ++cb) acc[cb] = (f32x4){0.f, 0.f, 0.f, 0.f};
    const LAS bf16_t* xlane = VnT + fr * GPX + 8 * fq + 8 * (fr >> 3);
#pragma unroll
    for (int ks = 0; ks < 4; ++ks) {
        const bf16x8 af = *(const LAS bf16x8*)(Wt + (16 * w + fr) * GP + 32 * ks + 8 * fq);
#pragma unroll
        for (int cb = 0; cb < 8; ++cb) {
            const bf16x8 bfv = *(const LAS bf16x8*)(xlane + (16 * cb * GPX + 16 * (cb & 3) + 32 * ks));
            acc[cb] = __builtin_amdgcn_mfma_f32_16x16x32_bf16(bfv, af, acc[cb], 0, 0, 0);
        }
    }
    const float rst = rs[tt];
    bf16_t* op = (bf16_t*)(P.ws + WS_R1) + ((size_t)chunk * 128 + tt) * MIXW + g * 128 + 4 * fq;
#pragma unroll
    for (int cb = 0; cb < 8; ++cb) {
        u32x2 ow; ow.x = pk2(bflo(uw[cb].x) * (ga[cb].x * acc[cb][0] + be[cb].x * rst + bs), bfhi(uw[cb].x) * (ga[cb].y * acc[cb][1] + be[cb].y * rst + bs));
        ow.y = pk2(bflo(uw[cb].y) * (ga[cb].z * acc[cb][2] + be[cb].z * rst + bs), bfhi(uw[cb].y) * (ga[cb].w * acc[cb][3] + be[cb].w * rst + bs));
        *(u32x2*)(op + 16 * cb) = ow;
    }
}
__device__ __forceinline__ void gate_prompt_loop(const Params& P, LAS unsigned char* lds, int l) {
    const int tid = opaque_tid(); const int G = gridDim.x;
    int u = opaque_bid();
    if (u >= 512) return;
    GatePre R; gate_prefetch(P, l, u, tid, R);
    int gcur = -1, buf = 0;
    for (;;) {
        if ((u & 3) != gcur) { if (gcur >= 0) __syncthreads(); gcur = u & 3; gate_stage_w(P, lds, l, gcur, tid); }
        u32x2 uc[8];
#pragma unroll
        for (int cb = 0; cb < 8; ++cb) uc[cb] = R.uw[cb];
        LAS unsigned char* xb = lds + GATE_XT + buf * GATE_XT_BYTES;
        gate_stage_x(xb, tid, R);
        const int un = u + G;
        if (un < 512) gate_prefetch(P, l, un, tid, R);
        __syncthreads();
        gate_compute(P, lds, xb, l, u, tid, uc);
        if (un >= 512) break;
        u = un; buf ^= 1;
    }
    __syncthreads();
}

__device__ __forceinline__ void sample_gc_unit(const Params& P, int l, int db) {
    const int tid = opaque_tid();
    const bf16_t* Z1 = (const bf16_t*)(P.ws + WS_Z1);
    const float* stats = (const float*)(P.ws + 65536) + (size_t)l * MR * 2;
    const size_t row0 = (size_t)(MPR + db * 4);
    const int c = tid, g = c >> 7;
    bf16_t* MIX = (bf16_t*)(P.ws + WS_R1);
    {
        const float lg = P.in[10][l * 512 + c], lb = P.in[11][l * 512 + c];
        float vn[4];
#pragma unroll
        for (int s = 0; s < 4; ++s) { const f32x2 sq = *(const f32x2*)(stats + (row0 + s) * 2);
            const float mean = sq.x * (1.f / 512.f); const float var = fmaxf(sq.y * (1.f / 512.f) - mean * mean, 0.f); const float rstd = 1.f / sqrtf(var + EPS);
            vn[s] = (bf1(Z1[ZB_GV + (row0 + s) * ZP_GV + c]) - mean) * rstd * lg + lb;
            P.out[O_AV + ((size_t)(l * 128 + db * 4 + s)) * 512 + c] = vn[s]; }
        const float* Wsrc = P.in[12] + (size_t)(l * 4 + g) * 128 * 128;
#pragma unroll
        for (int t = 0; t < 4; ++t) { float sa = P.in[13][(size_t)(l * 4 + g) * 128 + t];
#pragma unroll
            for (int s = 0; s < 4; ++s) if (s <= t) sa += Wsrc[t * 128 + s] * vn[s];
            MIX[(row0 + t) * MIXW + c] = (bf16_t)f2bf(bf1(Z1[ZB_U + (row0 + t) * ZP_U + c]) * sa); }
    }
    {
        float zp[6];
        zp[0] = P.in[4][((size_t)(l * 32 + db) * 2 + 0) * 512 + c]; zp[1] = P.in[4][((size_t)(l * 32 + db) * 2 + 1) * 512 + c];
#pragma unroll
        for (int t = 0; t < 4; ++t) zp[2 + t] = bf1(Z1[ZB_CX + (row0 + t) * ZP_CX + c]);
        const float w0 = P.in[14][(size_t)(l * 3 + 0) * 512 + c], w1 = P.in[14][(size_t)(l * 3 + 1) * 512 + c], w2 = P.in[14][(size_t)(l * 3 + 2) * 512 + c], cbias = P.in[15][l * 512 + c];
#pragma unroll
        for (int t = 0; t < 4; ++t) { const float conv = cbias + w0 * zp[t] + w1 * zp[t + 1] + w2 * zp[t + 2];
            MIX[(row0 + t) * MIXW + 768 + c] = (bf16_t)f2bf(bf1(Z1[ZB_CB + (row0 + t) * ZP_CB + c]) * conv); }
        P.out[O_CONVS + ((size_t)(l * 32 + db) * 2 + 0) * 512 + c] = zp[4];
        P.out[O_CONVS + ((size_t)(l * 32 + db) * 2 + 1) * 512 + c] = zp[5];
    }
}

__device__ __forceinline__ void conv_prompt_unit(const Params& P, int l, int rb) {
    const int tid = opaque_tid(), oc = tid & 63, rs = tid >> 6;
    const bf16_t* Z1 = (const bf16_t*)(P.ws + WS_Z1);
    bf16_t* MIX = (bf16_t*)(P.ws + WS_R1);
    const size_t row0 = (size_t)rb * 64 + rs * 8;
    const int s0 = (int)(row0 & (SEQ - 1)), bb = (int)(row0 >> 13);
    float w0[8], w1[8], w2[8], cbias[8], zm2[8], zm1[8];
    { const float* cw = P.in[14] + (size_t)l * 3 * 512 + 8 * oc; const float* cbp = P.in[15] + l * 512 + 8 * oc;
      const f32x4 a0 = *(const f32x4*)cw, a1 = *(const f32x4*)(cw + 4), b0 = *(const f32x4*)(cw + 512), b1 = *(const f32x4*)(cw + 516), c0 = *(const f32x4*)(cw + 1024), c1 = *(const f32x4*)(cw + 1028), d0 = *(const f32x4*)cbp, d1 = *(const f32x4*)(cbp + 4);
#pragma unroll
      for (int e = 0; e < 4; ++e) { w0[e] = a0[e]; w0[4 + e] = a1[e]; w1[e] = b0[e]; w1[4 + e] = b1[e]; w2[e] = c0[e]; w2[4 + e] = c1[e]; cbias[e] = d0[e]; cbias[4 + e] = d1[e]; } }
#pragma unroll
    for (int e = 0; e < 8; ++e) { zm2[e] = 0.f; zm1[e] = 0.f; }
    if (s0 >= 2) {
        const u32x4 a2 = *(const u32x4*)(Z1 + ZB_CX + (row0 - 2) * ZP_CX + 8 * oc), a1 = *(const u32x4*)(Z1 + ZB_CX + (row0 - 1) * ZP_CX + 8 * oc);
        zm2[0] = bflo(a2.x); zm2[1] = bfhi(a2.x); zm2[2] = bflo(a2.y); zm2[3] = bfhi(a2.y); zm2[4] = bflo(a2.z); zm2[5] = bfhi(a2.z); zm2[6] = bflo(a2.w); zm2[7] = bfhi(a2.w);
        zm1[0] = bflo(a1.x); zm1[1] = bfhi(a1.x); zm1[2] = bflo(a1.y); zm1[3] = bfhi(a1.y); zm1[4] = bflo(a1.z); zm1[5] = bfhi(a1.z); zm1[6] = bflo(a1.w); zm1[7] = bfhi(a1.w);
    }
#pragma unroll
    for (int i = 0; i < 8; ++i) {
        const size_t row = row0 + i;
        const u32x4 a = *(const u32x4*)(Z1 + ZB_CX + row * ZP_CX + 8 * oc), cbv = *(const u32x4*)(Z1 + ZB_CB + row * ZP_CB + 8 * oc);
        float z[8] = {bflo(a.x), bfhi(a.x), bflo(a.y), bfhi(a.y), bflo(a.z), bfhi(a.z), bflo(a.w), bfhi(a.w)};
        float cbf[8] = {bflo(cbv.x), bfhi(cbv.x), bflo(cbv.y), bfhi(cbv.y), bflo(cbv.z), bfhi(cbv.z), bflo(cbv.w), bfhi(cbv.w)};
        float oo[8];
#pragma unroll
        for (int e = 0; e < 8; ++e) { oo[e] = cbf[e] * (cbias[e] + w0[e] * zm2[e] + w1[e] * zm1[e] + w2[e] * z[e]); zm2[e] = zm1[e]; zm1[e] = z[e]; }
        u32x4 ow; ow.x = pk2(oo[0], oo[1]); ow.y = pk2(oo[2], oo[3]); ow.z = pk2(oo[4], oo[5]); ow.w = pk2(oo[6], oo[7]);
        *(u32x4*)(MIX + row * MIXW + 768 + 8 * oc) = ow;
        const int sp = s0 + i;
        if (sp >= SEQ - 2) { float* dst = P.out + O_CONVP + ((size_t)(l * 2 + bb) * 2 + (sp - (SEQ - 2))) * 512 + 8 * oc;
            *(f32x4*)dst = (f32x4){z[0], z[1], z[2], z[3]}; *(f32x4*)(dst + 4) = (f32x4){z[4], z[5], z[6], z[7]}; }
    }
}

__device__ __forceinline__ void phase_mixer(const Params& P, LAS unsigned char* lds, int l, int mask = 31) {
    const int bid = opaque_bid(), G = gridDim.x;
#define MIX_SAMPLE() do { if (mask & 1) { const int wv = __builtin_amdgcn_readfirstlane(opaque_tid() >> 6); const int wu0 = wv * G + bid; if (wu0 < 3072) attn_sample_wave(P, l, wu0); if (wu0 + 8 * G < 3072) attn_sample_wave(P, l, wu0 + 8 * G); \
        if (G < 192) for (int wu = wu0 + 16 * G; wu < 3072; wu += G * 8) attn_sample_wave(P, l, wu); } } while (0)
#define MIX_CONV() do { if (mask & 2) for (int u = bid; u < 32; u += G) sample_gc_unit(P, l, u); if (mask & 16) for (int u = bid; u < 256; u += G) conv_prompt_unit(P, l, u); } while (0)
    const bool conv_first = (bid & 1) == 0;
    if (conv_first) MIX_CONV(); else MIX_SAMPLE();
    if (mask & 4) gate_prompt_loop(P, lds, l);
    if (mask & 8) attn_prompt_loop(P, lds);
    if (conv_first) MIX_SAMPLE(); else MIX_CONV();
#undef MIX_SAMPLE
#undef MIX_CONV
}

__device__ __forceinline__ void phase_combine(const Params& P) {
    const bf16_t* og = (const bf16_t*)(P.ws + WS_R3); const float* lse = (const float*)(P.ws + WS_R3 + R3_LSE);
    bf16_t* MIX = (bf16_t*)(P.ws + WS_R1);
    const int nth = gridDim.x * 512; const int gtid = opaque_bid() * 512 + opaque_tid();
    if (gtid < 128 * 64) {
        const int rt = gtid >> 6, h = (gtid >> 4) & 3, dq = (gtid & 15) * 4;
        const float* ml = (const float*)(P.ws + WS_R3 + R3_SPML) + (size_t)rt * SPN * 8 + h * 2;
        const float* spo = (const float*)(P.ws + WS_R3 + R3_SPO) + (size_t)rt * SPN * 256 + h * 64 + dq;
        float M = -INFINITY;
#pragma unroll
        for (int i = 0; i < SPN; ++i) M = fmaxf(M, ml[i * 8]);
        f32x4 acc = (f32x4){0.f, 0.f, 0.f, 0.f}; float L = 0.f;
#pragma unroll
        for (int i = 0; i < SPN; ++i) { const float f = __expf(ml[i * 8] - M); L += f * ml[i * 8 + 1]; acc += *(const f32x4*)(spo + i * 256) * f; }
        const float rl = 1.f / L;
        u32x2 ow; ow.x = pk2(acc.x * rl, acc.y * rl); ow.y = pk2(acc.z * rl, acc.w * rl);
        *(u32x2*)(MIX + (size_t)(MPR + rt) * MIXW + 512 + h * 64 + dq) = ow;
    }
    for (int idx = gtid; idx < MPR * 32; idx += nth) {
        const int part = idx & 7, h = (idx >> 3) & 3; const size_t row = (size_t)(idx >> 5);
        const float l0 = lse[(0 * (size_t)MPR + row) * 4 + h], l1 = lse[(1 * (size_t)MPR + row) * 4 + h], l2 = lse[(2 * (size_t)MPR + row) * 4 + h];
        const float m = fmaxf(l0, fmaxf(l1, l2));
        float w0 = __expf(l0 - m), w1 = __expf(l1 - m), w2 = __expf(l2 - m); const float rs = 1.f / (w0 + w1 + w2); w0 *= rs; w1 *= rs; w2 *= rs;
        const u32x4 a = *(const u32x4*)(og + (0 * (size_t)MPR + row) * 256 + h * 64 + 8 * part);
        const u32x4 b = *(const u32x4*)(og + (1 * (size_t)MPR + row) * 256 + h * 64 + 8 * part);
        const u32x4 c = *(const u32x4*)(og + (2 * (size_t)MPR + row) * 256 + h * 64 + 8 * part);
        u32x4 o;
        o.x = pk2(w0 * bflo(a.x) + w1 * bflo(b.x) + w2 * bflo(c.x), w0 * bfhi(a.x) + w1 * bfhi(b.x) + w2 * bfhi(c.x));
        o.y = pk2(w0 * bflo(a.y) + w1 * bflo(b.y) + w2 * bflo(c.y), w0 * bfhi(a.y) + w1 * bfhi(b.y) + w2 * bfhi(c.y));
        o.z = pk2(w0 * bflo(a.z) + w1 * bflo(b.z) + w2 * bflo(c.z), w0 * bfhi(a.z) + w1 * bfhi(b.z) + w2 * bfhi(c.z));
        o.w = pk2(w0 * bflo(a.w) + w1 * bflo(b.w) + w2 * bflo(c.w), w0 * bfhi(a.w) + w1 * bfhi(b.w) + w2 * bfhi(c.w));
        *(u32x4*)(MIX + row * MIXW + 512 + h * 64 + 8 * part) = o;
    }
}

template <bool B> __device__ __forceinline__ void phase_rows(const Params& P, const bf16_t* mix, const bf16_t* ffn, bool x_from_input, const float* g1, const float* g2, const float* g3, const float* gnext) {
    const int tid = opaque_tid(), lane = tid & 63, wave = tid >> 6;
    const int gw = opaque_bid() * 8 + wave, NGW = gridDim.x * 8;
    bf16_t* H = (bf16_t*)(P.ws + WS_R1);
    for (int m = gw; m < MR; m += NGW) {
        const float* xr = x_from_input ? (m < MPR ? P.in[0] + (size_t)m * DM : P.in[1] + (size_t)(m - MPR) * DM) : P.out + (size_t)m * DM;
        f32x4 mv[4], xv[4], fv[4]; float s = 0.f, sf = 0.f;
#pragma unroll
        for (int j = 0; j < 4; ++j) { const u32x2 mw = *(const u32x2*)(mix + (size_t)m * DM + 4 * lane + 256 * j); mv[j] = (f32x4){bflo(mw.x), bfhi(mw.x), bflo(mw.y), bfhi(mw.y)};
            xv[j] = *(const f32x4*)(xr + 4 * lane + 256 * j); s += (mv[j].x * mv[j].x + mv[j].y * mv[j].y) + (mv[j].z * mv[j].z + mv[j].w * mv[j].w);
            if (B) { const u32x2 fw = *(const u32x2*)(ffn + (size_t)m * DM + 4 * lane + 256 * j); fv[j] = (f32x4){bflo(fw.x), bfhi(fw.x), bflo(fw.y), bfhi(fw.y)};
                sf += (fv[j].x * fv[j].x + fv[j].y * fv[j].y) + (fv[j].z * fv[j].z + fv[j].w * fv[j].w); } }
        const float r = 1.f / sqrtf(wave_sum(s) * (1.f / DM) + EPS);
        float rf = 0.f; if (B) rf = 1.f / sqrtf(wave_sum(sf) * (1.f / DM) + EPS);
        float s2 = 0.f;
#pragma unroll
        for (int j = 0; j < 4; ++j) { const f32x4 gg = *(const f32x4*)(g1 + 4 * lane + 256 * j); xv[j] = xv[j] + mv[j] * r * gg;
            if (B) { const f32x4 g3v = *(const f32x4*)(g3 + 4 * lane + 256 * j); xv[j] = xv[j] + fv[j] * rf * g3v; *(f32x4*)(P.out + (size_t)m * DM + 4 * lane + 256 * j) = xv[j]; }
            s2 += (xv[j].x * xv[j].x + xv[j].y * xv[j].y) + (xv[j].z * xv[j].z + xv[j].w * xv[j].w); }
        const float* gn = B ? gnext : g2;
        if (gn) {
            const float r2 = 1.f / sqrtf(wave_sum(s2) * (1.f / DM) + EPS);
#pragma unroll
            for (int j = 0; j < 4; ++j) { const f32x4 gg = *(const f32x4*)(gn + 4 * lane + 256 * j);
                u32x2 o; o.x = pk2(xv[j].x * r2 * gg.x, xv[j].y * r2 * gg.y); o.y = pk2(xv[j].z * r2 * gg.z, xv[j].w * r2 * gg.w);
                *(u32x2*)(H + (size_t)m * DM + 4 * lane + 256 * j) = o; }
        }
    }
}

template <int NSTEP> __device__ __forceinline__ void mini_acc(f32x4& acc, const bf16_t* ap, const bf16_t* bp) {
    bf16x8 a[NSTEP], b[NSTEP];
#pragma unroll
    for (int i = 0; i < NSTEP; ++i) { a[i] = *(const bf16x8*)(ap + 32 * i); b[i] = *(const bf16x8*)(bp + 32 * i); }
#pragma unroll
    for (int i = 0; i < NSTEP; ++i) acc = __builtin_amdgcn_mfma_f32_16x16x32_bf16(b[i], a[i], acc, 0, 0, 0);
}
template <int MODE> __device__ __forceinline__ void sample_gemm(LAS unsigned char* lds, const bf16_t* A, const bf16_t* Bt, bf16_t* O, const bf16_t* G) {
    const int tid = opaque_tid(), lane = tid & 63, w = tid >> 6, fr = lane & 15, fq = lane >> 4, kq = w & 3, half = w >> 2;
    LAS f32x4* red = (LAS f32x4*)lds;
    constexpr int LDA = MODE == 0 ? DM : (MODE == 1 ? FF : MIXW);
    for (int tile = opaque_bid() * 2 + half; tile < 512; tile += 2 * gridDim.x) {
        const int rb = tile >> 6, cb = tile & 63;
        const size_t row = (size_t)(MPR + 16 * rb + fr); const int col = 16 * cb + fr;
        const bf16_t* ap = A + row * LDA + 8 * fq; const bf16_t* bp = Bt + (size_t)col * LDA + 8 * fq;
        f32x4 acc = (f32x4){0.f, 0.f, 0.f, 0.f};
        const size_t orow = (size_t)(MPR + 16 * rb + fr); const int ocol = 16 * cb + 4 * fq;
        if constexpr (MODE == 0) { mini_acc<8>(acc, ap + 256 * kq, bp + 256 * kq); }
        else if constexpr (MODE == 1) { mini_acc<11>(acc, ap + 704 * kq, bp + 704 * kq); mini_acc<11>(acc, ap + 704 * kq + 352, bp + 704 * kq + 352); }
        else {
            f32x4 a0 = (f32x4){0.f, 0.f, 0.f, 0.f}, a1 = a0, a2 = a0;
            mini_acc<4>(a0, ap + 128 * kq, bp + 128 * kq);
            mini_acc<2>(a1, ap + 512 + 64 * kq, bp + 512 + 64 * kq);
            mini_acc<4>(a2, ap + 768 + 128 * kq, bp + 768 + 128 * kq);
            const bf16_t* gp = G + orow * GW + ocol;
            const u32x2 g0 = *(const u32x2*)gp, g1 = *(const u32x2*)(gp + DM), g2 = *(const u32x2*)(gp + 2 * DM);
            acc[0] = a0[0] * bflo(g0.x) + a1[0] * bflo(g1.x) + a2[0] * bflo(g2.x);
            acc[1] = a0[1] * bfhi(g0.x) + a1[1] * bfhi(g1.x) + a2[1] * bfhi(g2.x);
            acc[2] = a0[2] * bflo(g0.y) + a1[2] * bflo(g1.y) + a2[2] * bflo(g2.y);
            acc[3] = a0[3] * bfhi(g0.y) + a1[3] * bfhi(g1.y) + a2[3] * bfhi(g2.y);
        }
        if (kq > 0) red[(half * 3 + kq - 1) * 64 + lane] = acc;
        __syncthreads();
        if (kq == 0) {
            acc += red[(half * 3 + 0) * 64 + lane]; acc += red[(half * 3 + 1) * 64 + lane]; acc += red[(half * 3 + 2) * 64 + lane];
            u32x2 ow; ow.x = pk2(acc[0], acc[1]); ow.y = pk2(acc[2], acc[3]);
            *(u32x2*)(O + orow * DM + ocol) = ow;
        }
        __syncthreads();
    }
}

#define XB_TMO      128
#define XB_XCNT(j)  (256  + 64 * (j))
#define XB_XSUB(j)  (1280 + 64 * (j))
#define XB_XGEN(j)  (2304 + 64 * (j))
#define XB_TOP      3328
#define XB_TOPGEN   3392
#define XCD_BAR_WORDS 3456
#define XB_SPIN_CAP (1u << 18)
__device__ __forceinline__ unsigned xb_ld(unsigned* p)              { return __hip_atomic_load(p, __ATOMIC_RELAXED, __HIP_MEMORY_SCOPE_AGENT); }
__device__ __forceinline__ unsigned xb_add(unsigned* p, unsigned v) { return __hip_atomic_fetch_add(p, v, __ATOMIC_RELAXED, __HIP_MEMORY_SCOPE_AGENT); }
__device__ __forceinline__ unsigned xb_xcc_id() { return (unsigned)__builtin_amdgcn_s_getreg((3 << 11) | 20) & 0xFu; }
#define XB_SPIN(cond, bar) do { unsigned _sp = 0; while (cond) { __builtin_amdgcn_s_sleep(1); \
    if ((++_sp & 255u) == 0u) { if (xb_ld(&(bar)[XB_TMO])) break; if (_sp > XB_SPIN_CAP) { atomicAdd(&(bar)[XB_TMO], 1u); break; } } } } while (0)
struct XcdBarrier { unsigned* bar; unsigned x; volatile LAS unsigned* st; };
__device__ __forceinline__ XcdBarrier xcd_barrier_post(unsigned* bar, volatile LAS unsigned* st) {
    XcdBarrier b; b.bar = bar; b.x = xb_xcc_id(); b.st = st;
    if (threadIdx.x == 0) (void)xb_add(&bar[XB_XCNT(b.x)], 1u);
    return b;
}
__device__ __forceinline__ void xcd_barrier_complete(unsigned* bar, unsigned x, unsigned& nloc, unsigned& nx) {
    const unsigned G = gridDim.x * gridDim.y * gridDim.z;
    unsigned sum, cnt, mine, sp = 0u;
    for (;;) {
        sum = 0u; cnt = 0u; mine = 0u;
#pragma unroll
        for (unsigned j = 0; j < 16; ++j) { const unsigned c = xb_ld(&bar[XB_XCNT(j)]); sum += c; cnt += (c > 0u) ? 1u : 0u; mine = (j == x) ? c : mine; }
        if (sum == G) break;
        __builtin_amdgcn_s_sleep(1);
        if ((++sp & 255u) == 0u) { if (xb_ld(&bar[XB_TMO])) break; if (sp > XB_SPIN_CAP) { atomicAdd(&bar[XB_TMO], 1u); break; } }
    }
    nloc = mine > 0u ? mine : 1u; nx = cnt > 0u ? cnt : 1u;
}
__device__ __forceinline__ void xcd_barrier(const XcdBarrier& b) {
    asm volatile("s_waitcnt vmcnt(0)" ::: "memory");
    __syncthreads();
    if (threadIdx.x == 0) {
        unsigned* bar = b.bar;
        __builtin_amdgcn_s_waitcnt(0);
        unsigned nloc = b.st[0], nx = b.st[1];
        if (nloc == 0u) { xcd_barrier_complete(bar, b.x, nloc, nx); b.st[0] = nloc; b.st[1] = nx; }
        const unsigned old = xb_add(&bar[XB_XSUB(b.x)], 1u);
        const unsigned gen = old / nloc;
        if (old + 1u == (gen + 1u) * nloc) {
            __builtin_amdgcn_fence(__ATOMIC_RELEASE, "agent");
            asm volatile("s_waitcnt vmcnt(0)" ::: "memory");
            const unsigned og = xb_add(&bar[XB_TOP], 1u);
            const unsigned tg = og / nx;
            if (og + 1u == (tg + 1u) * nx) xb_add(&bar[XB_TOPGEN], 1u);
            else XB_SPIN(xb_ld(&bar[XB_TOPGEN]) == tg, bar);
            __builtin_amdgcn_fence(__ATOMIC_ACQUIRE, "agent");
            xb_add(&bar[XB_XGEN(b.x)], 1u);
            asm volatile("s_waitcnt vmcnt(0)" ::: "memory");
        } else {
            XB_SPIN(xb_ld(&bar[XB_XGEN(b.x)]) == gen, bar);
            __builtin_amdgcn_fence(__ATOMIC_ACQUIRE, "agent");
            asm volatile("s_waitcnt vmcnt(0)" ::: "memory");
        }
    }
    __syncthreads();
}

constexpr int PH_PER_LAYER = 9, N_PHASES = 1 + 2 * PH_PER_LAYER;
template <int PH> __device__ __forceinline__ void do_phase(const Params& P, LAS unsigned char* lds) {
    if constexpr (PH == 0) { phase_prologue(P, lds); }
    else {
        constexpr int l = (PH - 1) / PH_PER_LAYER, k = (PH - 1) % PH_PER_LAYER;
        const int G = gridDim.x;
        unsigned char* wl = P.ws + WS_W + (size_t)l * W_LAYER;
        bf16_t* R1 = (bf16_t*)(P.ws + WS_R1); bf16_t* R2 = (bf16_t*)(P.ws + WS_R2); bf16_t* R3 = (bf16_t*)(P.ws + WS_R3);
        bf16_t* Z1 = (bf16_t*)(P.ws + WS_Z1); bf16_t* GB = (bf16_t*)(P.ws + WS_G);
        pg8::StaticOrder S;
        if constexpr (k == 0) {
            pg8::Gemm g{R1, (const bf16_t*)(wl + WO_IN)}; S.init(MPAD, INW, G, opaque_bid());
            pg8::EpiIn E{Z1, GB, P.in[19] + (size_t)l * GW, P.out + O_KWIN + (size_t)l * 1048576, P.out + O_VWIN + (size_t)l * 1048576, P.out + O_KROW + (size_t)l * 32768, P.out + O_VROW + (size_t)l * 32768, (float*)(P.ws + 65536) + (size_t)l * MR * 2};
            pg8::gemm_phase<pg8::EpiIn, true, DM, DM, DM>(lds, g, S, E);
            if constexpr (l == 0) { const int nwg = (MPAD / 256) * (INW / 256); const int rounds = (nwg + G - 1) / G; const int nf = nwg - (rounds - 1) * G; const int b = opaque_bid();
                if (defer_layer1(G)) { if (G - nf >= 16) { if (b >= nf) convert_items(P, lds, 1, (b - nf) * 8 + (opaque_tid() >> 6), (G - nf) * 8, CV_SPLIT); }
                    else convert_items(P, lds, 1, b * 8 + (opaque_tid() >> 6), G * 8, CV_SPLIT); } }
        } else if constexpr (k == 1) { phase_mixer(P, lds, l); }
        else if constexpr (k == 2) { phase_combine(P); }
        else if constexpr (k == 3) {
            S.init(MPR, DM, G, opaque_bid()); pg8::Gemm g{R1, (const bf16_t*)(wl + WO_BR)}; pg8::EpiGated E{GB, R2};
            pg8::gemm_phase<pg8::EpiGated, true, MIXW, MIXW, MIXW>(lds, g, S, E);
            sample_gemm<2>(lds, R1, (const bf16_t*)(wl + WO_BR), R2, GB);
        } else if constexpr (k == 4) {
            pg8::Gemm g{R2, (const bf16_t*)(wl + WO_O)}; S.init(MPR, DM, G, opaque_bid());
            pg8::EpiBf16 E{R3, DM};
            pg8::gemm_phase<pg8::EpiBf16, true, DM, DM, DM>(lds, g, S, E);
            sample_gemm<0>(lds, R2, (const bf16_t*)(wl + WO_O), R3, nullptr);
        } else if constexpr (k == 5) { phase_rows<false>(P, R3, nullptr, l == 0, P.in[6] + (size_t)l * DM, P.in[7] + (size_t)l * DM, nullptr, nullptr); }
        else if constexpr (k == 6) {
            pg8::Gemm g{R1, (const bf16_t*)(wl + WO_GU)}; S.init(MPAD, 2 * FF, G, opaque_bid());
            pg8::EpiSwiglu E{Z1};
            pg8::gemm_phase<pg8::EpiSwiglu, true, DM, DM, DM>(lds, g, S, E);
            if constexpr (l == 0) { const int nf = up_full_blocks(G); const int b = opaque_bid();
                if (defer_layer1(G) && b >= nf) convert_items(P, lds, 1, CV_SPLIT + (b - nf) * 8 + (opaque_tid() >> 6), (G - nf) * 8); }
        } else if constexpr (k == 7) {
            pg8::Gemm g{Z1, (const bf16_t*)(wl + WO_D)}; S.init(MPR, DM, G, opaque_bid());
            pg8::EpiBf16 E{R2, DM};
            pg8::gemm_phase<pg8::EpiBf16, true, FF, FF, FF>(lds, g, S, E);
            sample_gemm<1>(lds, Z1, (const bf16_t*)(wl + WO_D), R2, nullptr);
        } else { phase_rows<true>(P, R3, R2, l == 0, P.in[6] + (size_t)l * DM, nullptr, P.in[8] + (size_t)l * DM, l + 1 < 2 ? P.in[5] + (size_t)(l + 1) * DM : nullptr); }
    }
    __syncthreads();
}

#ifndef PH_MASK
#define PH_MASK 0x7ffff
#endif
#ifndef PROBE_DUP
#define PROBE_DUP 0
#endif
#ifndef PROBE_MIX
#define PROBE_MIX 0
#endif
#ifndef PROBE_SYNCS
#define PROBE_SYNCS 0
#endif
__global__ void __launch_bounds__(512, 2) fwd_kernel(Params P) {
    extern __shared__ __attribute__((aligned(16))) unsigned char lds_raw[];
    LAS unsigned char* lds = (LAS unsigned char*)lds_raw;
    cg::grid_group grid = cg::this_grid();
    volatile LAS unsigned* stw = (volatile LAS unsigned*)(lds + LDS_BYTES - 64);
    if (threadIdx.x < 4) stw[threadIdx.x] = 0u;
    __syncthreads();
    XcdBarrier bar; bar.bar = (unsigned*)P.ws; bar.x = 0; bar.st = stw;
    if (P.ph_hi - P.ph_lo > 1) bar = xcd_barrier_post((unsigned*)P.ws, stw);
    if (P.ph_hi < 0) grid.sync();
#define RUN(ph) if (((PH_MASK >> ph) & 1) && P.ph_lo <= ph && ph < P.ph_hi) { if (ph > P.ph_lo) xcd_barrier(bar); do_phase<ph>(P, lds); if ((PROBE_DUP >> ph) & 1) { xcd_barrier(bar); do_phase<ph>(P, lds); } }
    for (int i = 0; i < PROBE_SYNCS; ++i) xcd_barrier(bar);
    RUN(0) RUN(1) RUN(2)
    if (PROBE_MIX) { xcd_barrier(bar); phase_mixer(P, lds, 0, PROBE_MIX); }
    RUN(3) RUN(4) RUN(5) RUN(6) RUN(7) RUN(8) RUN(9) RUN(10) RUN(11) RUN(12) RUN(13) RUN(14) RUN(15) RUN(16) RUN(17) RUN(18)
#undef RUN
}

extern "C" void kernel_launch(void* const* d_in, const int* in_sizes, int n_in, void* d_out, int out_size, void* d_ws, size_t ws_size, hipStream_t stream) {
    static int grid = 0;
    if (grid == 0) {
        int dev = 0, cus = 0, per_cu = 0;
        (void)hipGetDevice(&dev);
        (void)hipDeviceGetAttribute(&cus, hipDeviceAttributeMultiprocessorCount, dev);
        (void)hipFuncSetAttribute((const void*)fwd_kernel, hipFuncAttributeMaxDynamicSharedMemorySize, LDS_BYTES);
        (void)hipOccupancyMaxActiveBlocksPerMultiprocessor(&per_cu, (const void*)fwd_kernel, 512, LDS_BYTES);
        if (per_cu < 1) per_cu = 1;
        (void)hipGetLastError();
        grid = cus * 1;
        if (n_in != 24 || ws_size < WS_END) { fprintf(stderr, "kernel_launch: unexpected n_in %d / ws_size %zu\n", n_in, ws_size); }
    }
    (void)hipMemsetAsync(d_ws, 0, 524288, stream);
    Params p{};
    for (int i = 0; i < 24; ++i) p.in[i] = (const float*)d_in[i];
    p.out = (float*)d_out; p.ws = (unsigned char*)d_ws;
#if ONE_LAUNCH
    p.ph_lo = 0; p.ph_hi = N_PHASES;
    void* args[] = {&p};
    hipError_t e = hipLaunchCooperativeKernel((const void*)fwd_kernel, dim3(grid), dim3(512), args, LDS_BYTES, stream);
    if (e != hipSuccess) fprintf(stderr, "cooperative launch failed: %s (grid %d)\n", hipGetErrorString(e), grid);
#else
    for (int ph = 0; ph < N_PHASES; ++ph) {
        p.ph_lo = ph; p.ph_hi = ph + 1;
        hipLaunchKernelGGL(fwd_kernel, dim3(grid), dim3(512), LDS_BYTES, stream, p);
    }
#endif
}
```
